# Optimizing an MI355X kernel written in HIP

```python
import math
import jax, jax.numpy as jnp
from jax import lax
import numpy as np

D_MODEL = 2048
BATCH = 4
SEQ = 4096
DEPTH = 2

HEAD_DIM = 128
MOBA_HEADS = 8
MOBA_BLOCK = 256
MOBA_TOPK = 3
MOBA_Q_CHUNK = 32
SB_HEADS = 8
SB_Q_BLOCK = 128
POOL_WINDOWS = (2, 4, 8, 16)
POOL_GROUPS = len(POOL_WINDOWS)
POOL_GROUP = 256
POOL_WIDTH = POOL_GROUP * POOL_GROUPS
MOBA_WIDTH = MOBA_HEADS * HEAD_DIM
SB_WIDTH = SB_HEADS * HEAD_DIM
N_BRANCH = 3
IN_WIDTH = 3 * MOBA_WIDTH + POOL_WIDTH + 3 * SB_WIDTH + N_BRANCH * D_MODEL
D_FF = -(-8 * D_MODEL // (3 * 256)) * 256
REL_BUCKETS = 32
REL_MAX_EXACT = 16
REL_MAX_DIST = 2048
EPS = 1e-6
NEG = -1e30

kernel_name = "hybrid_moba_pool_stickbreak_block"


def rms_norm(x, g):
    xf = x.astype(jnp.float32)
    y = xf * lax.rsqrt(jnp.mean(xf * xf, axis=-1, keepdims=True) + EPS)
    return (y * g.astype(jnp.float32)).astype(x.dtype)


def rel_bucket(dist):
    n = jnp.maximum(dist, 0)
    nf = jnp.maximum(n, 1).astype(jnp.float32)
    large = REL_MAX_EXACT + (jnp.log(nf / REL_MAX_EXACT) / math.log(REL_MAX_DIST / REL_MAX_EXACT)
                             * (REL_BUCKETS - REL_MAX_EXACT)).astype(jnp.int32)
    large = jnp.minimum(large, REL_BUCKETS - 1)
    return jnp.where(n < REL_MAX_EXACT, n, large)


def moba_attention(q, k, v, rel_table):
    B, H, S, Dh = q.shape
    nb = -(-S // MOBA_BLOCK)
    pad = nb * MOBA_BLOCK - S
    kb = jnp.pad(k, ((0, 0), (0, 0), (0, pad), (0, 0))).reshape(B, H, nb, MOBA_BLOCK, Dh)
    vb = jnp.pad(v, ((0, 0), (0, 0), (0, pad), (0, 0))).reshape(B, H, nb, MOBA_BLOCK, Dh)
    kbar = jnp.mean(kb.astype(jnp.float32), axis=3)
    topk = min(MOBA_TOPK, nb)
    scale = Dh ** -0.5
    bi = jnp.arange(B)[:, None, None, None]
    hi = jnp.arange(H)[None, :, None, None]
    hi5 = jnp.arange(H)[None, :, None, None, None]
    blk_off = jnp.arange(MOBA_BLOCK)
    Q = MOBA_Q_CHUNK

    def chunk(c):
        t0 = c * Q
        qc = lax.dynamic_slice_in_dim(q, t0, Q, axis=2).astype(jnp.float32)
        pos = t0 + jnp.arange(Q)
        own = t0 // MOBA_BLOCK
        gate = jnp.einsum('bhqd,bhnd->bhqn', qc, kbar)
        gate = jnp.where(jnp.arange(nb) < own, gate, -jnp.inf)
        _, idx = lax.top_k(gate, topk)
        valid = jnp.arange(topk) < own
        ksel = kb[bi, hi, idx].astype(jnp.float32)
        vsel = vb[bi, hi, idx].astype(jnp.float32)
        s_sel = jnp.einsum('bhqd,bhqnkd->bhqnk', qc, ksel) * scale
        key_pos = idx[..., None] * MOBA_BLOCK + blk_off
        bias_sel = rel_table[hi5, rel_bucket(pos[:, None, None] - key_pos)].astype(jnp.float32)
        s_sel = jnp.where(valid[:, None], s_sel + bias_sel, NEG)
        k_own = lax.dynamic_index_in_dim(kb, own, axis=2, keepdims=False).astype(jnp.float32)
        v_own = lax.dynamic_index_in_dim(vb, own, axis=2, keepdims=False).astype(jnp.float32)
        d_own = pos[:, None] - (own * MOBA_BLOCK + blk_off)[None, :]
        s_own = jnp.einsum('bhqd,bhkd->bhqk', qc, k_own) * scale
        s_own = jnp.where(d_own >= 0, s_own + rel_table[:, rel_bucket(d_own)].astype(jnp.float32)[None], NEG)
        logits = jnp.concatenate([s_sel.reshape(B, H, Q, topk * MOBA_BLOCK), s_own], axis=-1)
        p = jax.nn.softmax(logits, axis=-1)
        p_sel = p[..., :topk * MOBA_BLOCK].reshape(B, H, Q, topk, MOBA_BLOCK)
        p_own = p[..., topk * MOBA_BLOCK:]
        return (jnp.einsum('bhqnk,bhqnkd->bhqd', p_sel, vsel)
                + jnp.einsum('bhqk,bhkd->bhqd', p_own, v_own))

    out = lax.map(chunk, jnp.arange(S // Q))
    return jnp.moveaxis(out, 0, 2).reshape(B, H, S, Dh).astype(q.dtype)


def stick_breaking_attention(q, k, v):
    B, H, S, Dh = q.shape
    scale = Dh ** -0.5
    outs = []
    for t0 in range(0, S, SB_Q_BLOCK):
        t1 = t0 + SB_Q_BLOCK
        qc = q[:, :, t0:t1].astype(jnp.float32)
        kc = k[:, :, :t1].astype(jnp.float32)
        vc = v[:, :, :t1].astype(jnp.float32)
        z = jnp.einsum('bhqd,bhkd->bhqk', qc, kc) * scale
        causal = jnp.arange(t1)[None, :] < jnp.arange(t0, t1)[:, None]
        log_beta = jax.nn.log_sigmoid(z)
        log_1m = jnp.where(causal, jax.nn.log_sigmoid(-z), 0.0)
        after = lax.cumsum(log_1m, axis=3, reverse=True) - log_1m
        a = jnp.where(causal, jnp.exp(log_beta + after), 0.0)
        outs.append(jnp.einsum('bhqk,bhkd->bhqd', a, vc))
    return jnp.concatenate(outs, axis=2).astype(q.dtype)


def multiscale_pool(u, w_grp, scale):
    B, S, _ = u.shape
    ug = u.astype(jnp.float32).reshape(B, S, POOL_GROUPS, POOL_GROUP)
    cs = jnp.concatenate([jnp.zeros((B, 1, POOL_GROUPS, POOL_GROUP), jnp.float32),
                          jnp.cumsum(ug, axis=1)], axis=1)
    t = jnp.arange(S)
    pooled = []
    for gi, w in enumerate(POOL_WINDOWS):
        lo = jnp.maximum(t + 1 - w, 0)
        cnt = (t + 1 - lo).astype(jnp.float32)
        mean = (cs[:, 1:, gi] - cs[:, lo, gi]) / cnt[:, None]
        pooled.append(mean - ug[:, :, gi])
    p = jnp.stack(pooled, axis=2)
    y = jnp.einsum('bsgc,gcd->bsgd', p, w_grp.astype(jnp.float32)).reshape(B, S, POOL_WIDTH)
    return (y * scale.astype(jnp.float32)).astype(u.dtype)


def hybrid_mixer(h, w_in, w_pool, pool_scale, w_br_a, w_br_b, w_br_c, w_out, rel_table):
    B, S, _ = h.shape
    proj = h @ w_in
    offs = np.cumsum([MOBA_WIDTH, MOBA_WIDTH, MOBA_WIDTH, POOL_WIDTH, SB_WIDTH, SB_WIDTH, SB_WIDTH]).tolist()
    qa, ka, va, u, qs, ks, vs, gates = jnp.split(proj, offs, axis=-1)
    to_heads = lambda t, nh: t.reshape(B, S, nh, HEAD_DIM).transpose(0, 2, 1, 3)
    from_heads = lambda t: t.transpose(0, 2, 1, 3).reshape(B, S, -1)
    ya = from_heads(moba_attention(to_heads(qa, MOBA_HEADS), to_heads(ka, MOBA_HEADS),
                                   to_heads(va, MOBA_HEADS), rel_table))
    yb = multiscale_pool(u, w_pool, pool_scale)
    yc = from_heads(stick_breaking_attention(to_heads(qs, SB_HEADS), to_heads(ks, SB_HEADS),
                                             to_heads(vs, SB_HEADS)))
    g = jax.nn.sigmoid(gates.astype(jnp.float32)).reshape(B, S, N_BRANCH, D_MODEL)
    m = (g[:, :, 0] * (ya @ w_br_a).astype(jnp.float32)
         + g[:, :, 1] * (yb @ w_br_b).astype(jnp.float32)
         + g[:, :, 2] * (yc @ w_br_c).astype(jnp.float32))
    return m.astype(h.dtype) @ w_out


def swiglu(h, w_gate, w_up, w_down):
    return (jax.nn.silu(h @ w_gate) * (h @ w_up)) @ w_down


def setup_inputs(seed: int = 0) -> dict:
    key = jax.random.key(seed)
    ks = jax.random.split(key, 16)
    nrm = lambda k, shape, fan: jax.random.normal(k, shape, jnp.float32) * (fan ** -0.5)
    return {
        "x": jax.random.normal(ks[0], (BATCH, SEQ, D_MODEL), jnp.float32),
        "norm_mix": 1.0 + 0.02 * jax.random.normal(ks[1], (DEPTH, D_MODEL), jnp.float32),
        "norm_ffn": 1.0 + 0.02 * jax.random.normal(ks[2], (DEPTH, D_MODEL), jnp.float32),
        "w_in": nrm(ks[3], (DEPTH, D_MODEL, IN_WIDTH), D_MODEL),
        "w_pool": nrm(ks[4], (DEPTH, POOL_GROUPS, POOL_GROUP, POOL_GROUP), POOL_GROUP),
        "pool_scale": 1.0 + 0.02 * jax.random.normal(ks[5], (DEPTH, POOL_WIDTH), jnp.float32),
        "w_br_a": nrm(ks[6], (DEPTH, MOBA_WIDTH, D_MODEL), MOBA_WIDTH),
        "w_br_b": nrm(ks[7], (DEPTH, POOL_WIDTH, D_MODEL), POOL_WIDTH),
        "w_br_c": nrm(ks[8], (DEPTH, SB_WIDTH, D_MODEL), SB_WIDTH),
        "w_out": nrm(ks[9], (DEPTH, D_MODEL, D_MODEL), D_MODEL),
        "w_gate": nrm(ks[10], (DEPTH, D_MODEL, D_FF), D_MODEL),
        "w_up": nrm(ks[11], (DEPTH, D_MODEL, D_FF), D_MODEL),
        "w_down": nrm(ks[12], (DEPTH, D_FF, D_MODEL), D_FF),
        "rel_bias": 0.5 * jax.random.normal(ks[13], (MOBA_HEADS, REL_BUCKETS), jnp.float32),
        "norm_final": 1.0 + 0.02 * jax.random.normal(ks[14], (D_MODEL,), jnp.float32),
    }


def reference(x, norm_mix, norm_ffn, w_in, w_pool, pool_scale, w_br_a, w_br_b, w_br_c,
              w_out, w_gate, w_up, w_down, rel_bias, norm_final):
    h = x
    for l in range(DEPTH):
        h = h + hybrid_mixer(rms_norm(h, norm_mix[l]), w_in[l], w_pool[l], pool_scale[l],
                             w_br_a[l], w_br_b[l], w_br_c[l], w_out[l], rel_bias)
        h = h + swiglu(rms_norm(h, norm_ffn[l]), w_gate[l], w_up[l], w_down[l])
    return rms_norm(h, norm_final)
```

```cpp
#include <hip/hip_runtime.h>
#include <hip/hip_cooperative_groups.h>
#include <cstdio>
namespace cg = cooperative_groups;

#define LAS __attribute__((address_space(3)))
#define DI __device__ __forceinline__
typedef unsigned short bf16_t;
typedef short bf16x8 __attribute__((ext_vector_type(8)));
typedef short s16x4 __attribute__((ext_vector_type(4)));
typedef float f32x4 __attribute__((ext_vector_type(4)));
typedef float f32x16 __attribute__((ext_vector_type(16)));
typedef unsigned u32x4 __attribute__((ext_vector_type(4)));
typedef unsigned u32x2 __attribute__((ext_vector_type(2)));

constexpr int DM = 2048, NBATCH = 4, SEQ = 4096, MTOK = NBATCH * SEQ, INW = 13312, DFF = 5632;
constexpr int PROJ_LD = 7168, GATE_LD = 6144, Y_LD = 3072;
constexpr float LOG2E = 1.4426950408889634f;

constexpr size_t SZ_WIN = (size_t)INW * DM * 2;
constexpr size_t SZ_WPOOL = (size_t)4 * 256 * 256 * 2;
constexpr size_t SZ_WBR1 = (size_t)DM * 1024 * 2;
constexpr size_t SZ_WOUT = (size_t)DM * DM * 2;
constexpr size_t SZ_WGU = (size_t)2 * DFF * DM * 2;
constexpr size_t SZ_WDOWN = (size_t)DM * DFF * 2;
constexpr size_t OFF_WIN = 0;
constexpr size_t OFF_WPOOL = OFF_WIN + SZ_WIN;
constexpr size_t OFF_WBR = OFF_WPOOL + SZ_WPOOL;
constexpr size_t OFF_WOUT = OFF_WBR + 3 * SZ_WBR1;
constexpr size_t OFF_WGU = OFF_WOUT + SZ_WOUT;
constexpr size_t OFF_WDOWN = OFF_WGU + SZ_WGU;
constexpr size_t OFF_PROJ = OFF_WDOWN + SZ_WDOWN;
constexpr size_t OFF_GATES = OFF_PROJ + (size_t)MTOK * PROJ_LD * 2;
constexpr size_t OFF_XB = OFF_GATES + (size_t)MTOK * GATE_LD * 2;
constexpr size_t OFF_Y = OFF_XB + (size_t)MTOK * DM * 2;
constexpr size_t OFF_P = OFF_Y + (size_t)MTOK * Y_LD * 2;
constexpr size_t OFF_SSQ = OFF_P + (size_t)MTOK * 1024 * 2;
constexpr size_t OFF_KBAR = OFF_SSQ + (size_t)MTOK * 32 * 4;
constexpr size_t WS_NEED = OFF_KBAR + (size_t)4 * 8 * 16 * 128 * 4;

struct Params {
  const float *x, *norm_mix, *norm_ffn, *w_in, *w_pool, *pool_scale, *w_br_a, *w_br_b, *w_br_c, *w_out, *w_gate, *w_up, *w_down, *rel_bias, *norm_final;
  float* out;
  char* ws;
  int phase_lo, phase_hi;
};

DI int opaque_tid() { int t = threadIdx.x; asm volatile("" : "+v"(t)); return t; }
DI unsigned pk_bf16(float lo, float hi) { unsigned r; asm("v_cvt_pk_bf16_f32 %0, %1, %2" : "=v"(r) : "v"(lo), "v"(hi)); return r; }
DI float bflo(unsigned v) { return __uint_as_float(v << 16); }
DI float bfhi(unsigned v) { return __uint_as_float(v & 0xffff0000u); }
DI float fexp2(float x) { return __builtin_amdgcn_exp2f(x); }
DI float flog2(float x) { return __builtin_amdgcn_logf(x); }
DI f32x16 mfma32(bf16x8 a, bf16x8 b, f32x16 c) { return __builtin_amdgcn_mfma_f32_32x32x16_bf16(a, b, c, 0, 0, 0); }

DI void cvt_job(const float* __restrict__ src, bf16_t* __restrict__ dst, int K, int N, const float* __restrict__ rscale, const float* __restrict__ cscale,
                int blk, int blkstride, int off, char* shm) {
  float* tile = (float*)shm;
  const int tid = opaque_tid(), lane = tid & 63, w = tid >> 6;
  const int ntn = N >> 8, ntiles = (K >> 6) * ntn;
  for (int t = blockIdx.x; t < ntiles; t += gridDim.x) {
    const int kt = t / ntn, nt = t - kt * ntn, k0 = kt * 64, n0 = nt * 256;
    f32x4 v[8];
#pragma unroll
    for (int i = 0; i < 8; ++i) { const int idx = tid + 512 * i, k = idx >> 6, n4 = idx & 63; v[i] = *(const f32x4*)(src + (size_t)(k0 + k) * N + n0 + 4 * n4); }
    __syncthreads();
#pragma unroll
    for (int i = 0; i < 8; ++i) { const int idx = tid + 512 * i, k = idx >> 6, n4 = idx & 63; *(f32x4*)(tile + k * 256 + 4 * (n4 ^ ((k >> 3) & 7))) = v[i]; }
    __syncthreads();
    const int kc = lane >> 3;
    f32x4 g0 = {1.f, 1.f, 1.f, 1.f}, g1 = g0;
    if (rscale) { g0 = *(const f32x4*)(rscale + k0 + kc * 8); g1 = *(const f32x4*)(rscale + k0 + kc * 8 + 4); }
#pragma unroll
    for (int pass = 0; pass < 4; ++pass) {
      const int n = 32 * w + 8 * pass + (lane & 7);
      float f[8];
#pragma unroll
      for (int j = 0; j < 8; ++j) f[j] = tile[(kc * 8 + j) * 256 + 4 * ((n >> 2) ^ kc) + (n & 3)];
      const int ng = n0 + n;
      const float c = cscale ? cscale[ng] : 1.f;
      u32x4 o;
      o[0] = pk_bf16(f[0] * g0[0] * c, f[1] * g0[1] * c); o[1] = pk_bf16(f[2] * g0[2] * c, f[3] * g0[3] * c);
      o[2] = pk_bf16(f[4] * g1[0] * c, f[5] * g1[1] * c); o[3] = pk_bf16(f[6] * g1[2] * c, f[7] * g1[3] * c);
      const int q = ng / blk, drow = q * blkstride + off + (ng - q * blk);
      *(u32x4*)(dst + (size_t)drow * K + k0 + kc * 8) = o;
    }
  }
}

DI void convert_layer(const Params& p, int l, char* shm) {
  char* ws = p.ws;
  for (int job = 0; job < 12; ++job) {
    const float* src; bf16_t* dst; int K, N, blk, bs = 0, off = 0; const float* rs = nullptr; const float* cs = nullptr;
    if (job == 0) { src = p.w_in + (size_t)l * DM * INW; dst = (bf16_t*)(ws + OFF_WIN); K = DM; N = INW; blk = INW; rs = p.norm_mix + l * DM; }
    else if (job < 5) { const int g = job - 1; src = p.w_pool + ((size_t)l * 4 + g) * 65536; dst = (bf16_t*)(ws + OFF_WPOOL) + g * 65536; K = 256; N = 256; blk = 256; cs = p.pool_scale + l * 1024 + g * 256; }
    else if (job < 8) { const int b = job - 5; src = (b == 0 ? p.w_br_a : b == 1 ? p.w_br_b : p.w_br_c) + (size_t)l * 1024 * DM; dst = (bf16_t*)(ws + OFF_WBR + b * SZ_WBR1); K = 1024; N = DM; blk = DM; }
    else if (job == 8) { src = p.w_out + (size_t)l * DM * DM; dst = (bf16_t*)(ws + OFF_WOUT); K = DM; N = DM; blk = DM; }
    else if (job < 11) { src = (job == 9 ? p.w_gate : p.w_up) + (size_t)l * DM * DFF; dst = (bf16_t*)(ws + OFF_WGU); K = DM; N = DFF; blk = 128; bs = 256; off = (job == 9 ? 0 : 128); rs = p.norm_ffn + l * DM; }
    else { src = p.w_down + (size_t)l * DFF * DM; dst = (bf16_t*)(ws + OFF_WDOWN); K = DFF; N = DM; blk = DM; }
    cvt_job(src, dst, K, N, rs, cs, blk, bs, off, shm);
  }
}

DI void x_prep(const Params& p) {
  const int tid = opaque_tid(), lane = tid & 63, w = tid >> 6;
  bf16_t* xb = (bf16_t*)(p.ws + OFF_XB); float* ssq = (float*)(p.ws + OFF_SSQ);
  for (int row = blockIdx.x * 8 + w; row < MTOK; row += gridDim.x * 8) {
    float s = 0.f;
#pragma unroll
    for (int i = 0; i < 8; ++i) {
      const int c = (i * 64 + lane) * 4;
      const f32x4 v = *(const f32x4*)(p.x + (size_t)row * DM + c);
      s += v[0] * v[0] + v[1] * v[1] + v[2] * v[2] + v[3] * v[3];
      u32x2 o; o[0] = pk_bf16(v[0], v[1]); o[1] = pk_bf16(v[2], v[3]);
      *(u32x2*)(xb + (size_t)row * DM + c) = o;
    }
    s += __shfl_xor(s, 32);
    if (lane < 32) ssq[(size_t)row * 32 + lane] = s;
  }
}

DI void final_norm(const Params& p) {
  const int tid = opaque_tid(), lane = tid & 63, w = tid >> 6;
  const float* ssq = (const float*)(p.ws + OFF_SSQ);
  for (int row = blockIdx.x * 8 + w; row < MTOK; row += gridDim.x * 8) {
    float s = (lane < 32) ? ssq[(size_t)row * 32 + lane] : 0.f;
#pragma unroll
    for (int o = 32; o >= 1; o >>= 1) s += __shfl_xor(s, o);
    const float r = rsqrtf(s * (1.f / DM) + 1e-6f);
#pragma unroll
    for (int i = 0; i < 8; ++i) {
      const int c = (i * 64 + lane) * 4;
      f32x4 v = *(const f32x4*)(p.out + (size_t)row * DM + c);
      const f32x4 g = *(const f32x4*)(p.norm_final + c);
      v[0] *= r * g[0]; v[1] *= r * g[1]; v[2] *= r * g[2]; v[3] *= r * g[3];
      *(f32x4*)(p.out + (size_t)row * DM + c) = v;
    }
  }
}

DI void kbar_pool_phase(const Params& p, char* shm) {
  const bf16_t* proj = (const bf16_t*)(p.ws + OFF_PROJ);
  float* kbar = (float*)(p.ws + OFF_KBAR);
  bf16_t* P = (bf16_t*)(p.ws + OFF_P);
  const int tid = opaque_tid();
  float* red = (float*)shm;
  for (int u = blockIdx.x; u < 256; u += gridDim.x) {
    const int b = u >> 6, blk = (u >> 2) & 15, qtr = u & 3;
    const int cp = tid & 127, rg = tid >> 7;
    const int col = 1024 + qtr * 256 + cp * 2;
    float s0 = 0.f, s1 = 0.f;
    const bf16_t* base = proj + ((size_t)b * SEQ + blk * 256 + rg * 64) * PROJ_LD + col;
#pragma unroll 8
    for (int i = 0; i < 64; ++i) { const unsigned v = *(const unsigned*)(base + (size_t)i * PROJ_LD); s0 += bflo(v); s1 += bfhi(v); }
    __syncthreads();
    red[rg * 256 + cp * 2] = s0; red[rg * 256 + cp * 2 + 1] = s1;
    __syncthreads();
    if (tid < 256) {
      const float s = red[tid] + red[256 + tid] + red[512 + tid] + red[768 + tid];
      const int ca = qtr * 256 + tid, h = ca >> 7, d = ca & 127;
      kbar[(((size_t)b * 8 + h) * 16 + blk) * 128 + d] = s * (1.f / 256.f);
    }
  }
  for (int idx = blockIdx.x * 512 + tid; idx < MTOK * 128; idx += gridDim.x * 512) {
    const int tok = idx >> 7, c = (idx & 127) * 8, g = c >> 8, win = 2 << g, s = tok & (SEQ - 1);
    const int cnt = min(win, s + 1);
    float acc[8] = {0.f, 0.f, 0.f, 0.f, 0.f, 0.f, 0.f, 0.f};
    float self[8];
    const bf16_t* up = proj + (size_t)tok * PROJ_LD + 3072 + c;
    for (int j = 0; j < cnt; ++j) {
      const u32x4 v = *(const u32x4*)(up - (size_t)j * PROJ_LD);
#pragma unroll
      for (int e = 0; e < 4; ++e) { acc[2 * e] += bflo(v[e]); acc[2 * e + 1] += bfhi(v[e]); }
      if (j == 0) {
#pragma unroll
        for (int e = 0; e < 4; ++e) { self[2 * e] = bflo(v[e]); self[2 * e + 1] = bfhi(v[e]); }
      }
    }
    const float inv = 1.f / (float)cnt;
    u32x4 o;
#pragma unroll
    for (int e = 0; e < 4; ++e) o[e] = pk_bf16(acc[2 * e] * inv - self[2 * e], acc[2 * e + 1] * inv - self[2 * e + 1]);
    *(u32x4*)(P + (size_t)tok * 1024 + c) = o;
  }
}

constexpr int BK = 64, HALF = 128, HT = HALF * BK;
constexpr int GEMM_LDS = 8 * HT * 2;
constexpr int RS_OFF = GEMM_LDS;
enum { EPI_IN = 0, EPI_POOL = 1, EPI_BR = 2, EPI_RES = 3, EPI_FFN1 = 4 };

DI int lds_byte(int r, int c) { const int st = (r >> 4) * 2 + (c >> 5), rr = r & 15, cc = c & 31, ob = rr * 64 + cc * 2; return st * 1024 + (ob ^ (((ob >> 9) & 1) << 5)); }
DI void stage_rc(int b, int& R, int& C) { const int st = b / 1024, sb = b % 1024, swz = sb ^ (((sb >> 9) & 1) << 5); R = (st >> 1) * 16 + swz / 64; C = (st & 1) * 32 + (swz % 64) / 2; }

DI void gemm_unit(const Params& p, const bf16_t* __restrict__ A, int lda, const bf16_t* __restrict__ Bt, int ldb, int K,
                  int brow, int bcol, int kind, int ocol, int aux, const float* hin, char* shmc) {
  LAS unsigned char* lds = (LAS unsigned char*)shmc;
  const int tid = opaque_tid();
  const int wid = __builtin_amdgcn_readfirstlane(tid >> 6), lane = tid & 63, wr = wid >> 2, wc = wid & 3, fr = lane & 15, fq = lane >> 4;
  unsigned voffA[2], voffB[2];
#pragma unroll
  for (int i = 0; i < 2; ++i) { int R, C; stage_rc(tid * 16 + i * 8192, R, C); voffA[i] = (unsigned)(R * lda + C) * 2u; voffB[i] = (unsigned)(R * ldb + C) * 2u; }
  const unsigned ldsw = (unsigned)wid * 1024u;
  const int aoff = lds_byte(wr * 64 + fr, fq * 8), boff = lds_byte(wc * 32 + fr, fq * 8);
  const char* cA = (const char*)A + (size_t)brow * lda * 2;
  const char* cB = (const char*)Bt + (size_t)bcol * ldb * 2;
  const size_t hA = (size_t)HALF * lda * 2, hB = (size_t)HALF * ldb * 2;
#define SA(b, h) (((b) * 2 + (h)) * (HT * 2))
#define SB(b, h) ((4 + (b) * 2 + (h)) * (HT * 2))
#define STAGE(bufoff, gbase, voff) do { _Pragma("unroll") for (int _i = 0; _i < 2; ++_i) \
    __builtin_amdgcn_global_load_lds((const unsigned*)((gbase) + (voff)[_i]), (LAS unsigned*)(lds + (bufoff) + ldsw + _i * 8192), 16, 0, 0); } while (0)
#define STA(P, hf, kt) STAGE(P, cA + (hf) * hA + (size_t)(kt) * (BK * 2), voffA)
#define STB(P, hf, kt) STAGE(P, cB + (hf) * hB + (size_t)(kt) * (BK * 2), voffB)
#define LDA(dst, b, h) do { _Pragma("unroll") for (int m = 0; m < 4; ++m) _Pragma("unroll") for (int k = 0; k < 2; ++k) dst[m][k] = *(const LAS bf16x8*)(lds + SA(b, h) + aoff + m * 2048 + k * 1024); } while (0)
#define LDB(dst, b, h) do { _Pragma("unroll") for (int n = 0; n < 2; ++n) _Pragma("unroll") for (int k = 0; k < 2; ++k) dst[n][k] = *(const LAS bf16x8*)(lds + SB(b, h) + boff + n * 2048 + k * 1024); } while (0)
#define MMA(ai, bj, Af, Bf) do { __builtin_amdgcn_s_setprio(1); \
    _Pragma("unroll") for (int m = 0; m < 4; ++m) _Pragma("unroll") for (int n = 0; n < 2; ++n) _Pragma("unroll") for (int k = 0; k < 2; ++k) \
      acc[ai][bj][m][n] = __builtin_amdgcn_mfma_f32_16x16x32_bf16(Bf[n][k], Af[m][k], acc[ai][bj][m][n], 0, 0, 0); \
    __builtin_amdgcn_s_setprio(0); } while (0)
#define WAIT_V(n) asm volatile("s_waitcnt vmcnt(" #n ")" ::: "memory")
#define WAIT_L(n) asm volatile("s_waitcnt lgkmcnt(" #n ")" ::: "memory")
#define BAR __builtin_amdgcn_s_barrier()
#define SCHED __builtin_amdgcn_sched_barrier(0)

  float* rsl = (float*)(shmc + RS_OFF);
  __syncthreads();
  if (kind == EPI_IN || kind == EPI_FFN1) {
    if (tid < 256) {
      const float* sp = (const float*)(p.ws + OFF_SSQ) + (size_t)(brow + tid) * 32;
      float s = 0.f;
#pragma unroll
      for (int i = 0; i < 8; ++i) { const f32x4 v = *(const f32x4*)(sp + 4 * i); s += (v[0] + v[1]) + (v[2] + v[3]); }
      rsl[tid] = rsqrtf(s * (1.f / DM) + 1e-6f);
    }
  }
  f32x4 acc[2][2][4][2];
#pragma unroll
  for (int a = 0; a < 2; ++a)
#pragma unroll
    for (int b = 0; b < 2; ++b)
#pragma unroll
      for (int m = 0; m < 4; ++m)
#pragma unroll
        for (int n = 0; n < 2; ++n) acc[a][b][m][n] = (f32x4){0.f, 0.f, 0.f, 0.f};
  bf16x8 At[4][2], B0[2][2], B1[2][2];
  const int nt = K / BK;
  STB(SB(0, 0), 0, 0); STA(SA(0, 0), 0, 0);
  STB(SB(0, 1), 1, 0); STA(SA(0, 1), 1, 0);
  if (wr == 1) BAR;
  WAIT_V(4); BAR;
  STB(SB(1, 0), 0, 1); STA(SA(1, 0), 0, 1); STB(SB(1, 1), 1, 1);
  WAIT_V(6); BAR;
  for (int t = 0; t < nt - 2; t += 2) {
    LDB(B0, 0, 0); SCHED; LDA(At, 0, 0); STA(SA(1, 1), 1, t + 1);
    WAIT_L(8); BAR; WAIT_L(0); MMA(0, 0, At, B0); BAR; SCHED;
    LDB(B1, 0, 1); STB(SB(0, 0), 0, t + 2);
    BAR; WAIT_L(0); MMA(0, 1, At, B1); BAR;
    LDA(At, 0, 1); STA(SA(0, 0), 0, t + 2);
    BAR; WAIT_L(0); MMA(1, 0, At, B0); BAR; SCHED;
    STB(SB(0, 1), 1, t + 2);
    WAIT_V(6); BAR; MMA(1, 1, At, B1); BAR;
    LDB(B0, 1, 0); SCHED; LDA(At, 1, 0); STA(SA(0, 1), 1, t + 2);
    WAIT_L(8); BAR; WAIT_L(0); MMA(0, 0, At, B0); BAR; SCHED;
    LDB(B1, 1, 1); STB(SB(1, 0), 0, t + 3);
    BAR; WAIT_L(0); MMA(0, 1, At, B1); BAR;
    LDA(At, 1, 1); STA(SA(1, 0), 0, t + 3);
    BAR; WAIT_L(0); MMA(1, 0, At, B0); BAR; SCHED;
    STB(SB(1, 1), 1, t + 3);
    WAIT_V(6); BAR; MMA(1, 1, At, B1); BAR;
  }
  { LDB(B0, 0, 0); LDA(At, 0, 0); STA(SA(1, 1), 1, nt - 1);
    BAR; WAIT_L(0); MMA(0, 0, At, B0); BAR;
    LDB(B1, 0, 1); BAR; WAIT_L(0); MMA(0, 1, At, B1); BAR;
    LDA(At, 0, 1); WAIT_V(4); BAR; WAIT_L(0); MMA(1, 0, At, B0); MMA(1, 1, At, B1); BAR; }
  { LDB(B0, 1, 0); LDA(At, 1, 0); WAIT_V(2); BAR; WAIT_L(0); MMA(0, 0, At, B0); BAR;
    LDB(B1, 1, 1); WAIT_V(0); BAR; WAIT_L(0); MMA(0, 1, At, B1); BAR;
    LDA(At, 1, 1); BAR; WAIT_L(0); MMA(1, 0, At, B0); MMA(1, 1, At, B1); BAR; }
  if (wr == 0) BAR;

  char* ws = p.ws;
  if (kind == EPI_IN) {
    const bool isgate = ocol >= PROJ_LD;
    bf16_t* obase = isgate ? (bf16_t*)(ws + OFF_GATES) + (ocol - PROJ_LD) : (bf16_t*)(ws + OFF_PROJ) + ocol;
    const int old = isgate ? GATE_LD : PROJ_LD;
#pragma unroll
    for (int ai = 0; ai < 2; ++ai)
#pragma unroll
      for (int m = 0; m < 4; ++m) {
        const int rl = ai * HALF + wr * 64 + m * 16 + fr;
        const float rs = rsl[rl];
        bf16_t* rowp = obase + (size_t)(brow + rl) * old + wc * 32 + 4 * fq;
#pragma unroll
        for (int bj = 0; bj < 2; ++bj)
#pragma unroll
          for (int n = 0; n < 2; ++n) {
            f32x4 v = acc[ai][bj][m][n] * rs;
            if (isgate) {
#pragma unroll
              for (int j = 0; j < 4; ++j) v[j] = __builtin_amdgcn_rcpf(1.f + fexp2(-LOG2E * v[j]));
            }
            u32x2 o; o[0] = pk_bf16(v[0], v[1]); o[1] = pk_bf16(v[2], v[3]);
            *(u32x2*)(rowp + bj * HALF + n * 16) = o;
          }
      }
  } else if (kind == EPI_POOL) {
    bf16_t* obase = (bf16_t*)(ws + OFF_Y) + ocol;
#pragma unroll
    for (int ai = 0; ai < 2; ++ai)
#pragma unroll
      for (int m = 0; m < 4; ++m) {
        const int rl = ai * HALF + wr * 64 + m * 16 + fr;
        bf16_t* rowp = obase + (size_t)(brow + rl) * Y_LD + wc * 32 + 4 * fq;
#pragma unroll
        for (int bj = 0; bj < 2; ++bj)
#pragma unroll
          for (int n = 0; n < 2; ++n) {
            const f32x4 v = acc[ai][bj][m][n];
            u32x2 o; o[0] = pk_bf16(v[0], v[1]); o[1] = pk_bf16(v[2], v[3]);
            *(u32x2*)(rowp + bj * HALF + n * 16) = o;
          }
      }
  } else if (kind == EPI_BR) {
    const bf16_t* gbase = (const bf16_t*)(ws + OFF_GATES) + aux * DM + ocol;
    bf16_t* mbase = (bf16_t*)(ws + OFF_PROJ) + ocol;
#pragma unroll
    for (int ai = 0; ai < 2; ++ai)
#pragma unroll
      for (int m = 0; m < 4; ++m) {
        const int rl = ai * HALF + wr * 64 + m * 16 + fr;
        const bf16_t* grow = gbase + (size_t)(brow + rl) * GATE_LD + wc * 32 + 4 * fq;
        bf16_t* mrow = mbase + (size_t)(brow + rl) * DM + wc * 32 + 4 * fq;
#pragma unroll
        for (int bj = 0; bj < 2; ++bj)
#pragma unroll
          for (int n = 0; n < 2; ++n) {
            const u32x2 g = *(const u32x2*)(grow + bj * HALF + n * 16);
            f32x4 v = acc[ai][bj][m][n];
            v[0] *= bflo(g[0]); v[1] *= bfhi(g[0]); v[2] *= bflo(g[1]); v[3] *= bfhi(g[1]);
            if (aux != 0) { const u32x2 mo = *(const u32x2*)(mrow + bj * HALF + n * 16); v[0] += bflo(mo[0]); v[1] += bfhi(mo[0]); v[2] += bflo(mo[1]); v[3] += bfhi(mo[1]); }
            u32x2 o; o[0] = pk_bf16(v[0], v[1]); o[1] = pk_bf16(v[2], v[3]);
            *(u32x2*)(mrow + bj * HALF + n * 16) = o;
          }
      }
  } else if (kind == EPI_RES) {
    bf16_t* xb = (bf16_t*)(ws + OFF_XB) + ocol;
    float* ssq = (float*)(ws + OFF_SSQ);
    const int pslot = (ocol >> 8) * 4 + wc;
#pragma unroll
    for (int ai = 0; ai < 2; ++ai)
#pragma unroll
      for (int m = 0; m < 4; ++m) {
        const int rl = ai * HALF + wr * 64 + m * 16 + fr;
        const size_t ro = (size_t)(brow + rl) * DM + ocol + wc * 32 + 4 * fq;
        float s = 0.f;
#pragma unroll
        for (int bj = 0; bj < 2; ++bj)
#pragma unroll
          for (int n = 0; n < 2; ++n) {
            const f32x4 hv = *(const f32x4*)(hin + ro + bj * HALF + n * 16);
            const f32x4 v = acc[ai][bj][m][n] + hv;
            *(f32x4*)(p.out + ro + bj * HALF + n * 16) = v;
            s += v[0] * v[0] + v[1] * v[1] + v[2] * v[2] + v[3] * v[3];
            u32x2 o; o[0] = pk_bf16(v[0], v[1]); o[1] = pk_bf16(v[2], v[3]);
            *(u32x2*)(xb + (size_t)(brow + rl) * DM + wc * 32 + 4 * fq + bj * HALF + n * 16) = o;
          }
        s += __shfl_xor(s, 16); s += __shfl_xor(s, 32);
        if (fq == 0) ssq[(size_t)(brow + rl) * 32 + pslot] = s;
      }
  } else {
    bf16_t* abase = (bf16_t*)(ws + OFF_PROJ) + ocol;
#pragma unroll
    for (int ai = 0; ai < 2; ++ai)
#pragma unroll
      for (int m = 0; m < 4; ++m) {
        const int rl = ai * HALF + wr * 64 + m * 16 + fr;
        const float rs = rsl[rl];
        bf16_t* rowp = abase + (size_t)(brow + rl) * DFF + wc * 32 + 4 * fq;
#pragma unroll
        for (int n = 0; n < 2; ++n) {
          const f32x4 g = acc[ai][0][m][n] * rs, u = acc[ai][1][m][n] * rs;
          f32x4 v;
#pragma unroll
          for (int j = 0; j < 4; ++j) v[j] = g[j] * __builtin_amdgcn_rcpf(1.f + fexp2(-LOG2E * g[j])) * u[j];
          u32x2 o; o[0] = pk_bf16(v[0], v[1]); o[1] = pk_bf16(v[2], v[3]);
          *(u32x2*)(rowp + n * 16) = o;
        }
      }
  }
}

DI bool tile_order(int L, int nM, int nN, int& pm, int& pn) {
  const int nwg = nM * nN; if (L >= nwg) return false;
  int wgid = L; { const int q = nwg / 8, r = nwg % 8, xcd = wgid % 8, off = wgid / 8; wgid = (xcd < r ? xcd * (q + 1) : r * (q + 1) + (xcd - r) * q) + off; }
  const int nig = 8 * nN, gid = wgid / nig, fm = gid * 8, gsz = (nM - fm) < 8 ? (nM - fm) : 8;
  pm = fm + ((wgid % nig) % gsz); pn = (wgid % nig) / gsz; return true;
}

constexpr int KP = 272, VP = 320, KBUF = 64 * KP, VBUF = 64 * VP;
constexpr int AT_V = 2 * KBUF, AT_BT = AT_V + 2 * VBUF, AT_KB = AT_BT + 16384, AT_SM = AT_KB + 8192, AT_FL = AT_SM + 1024;

DI int rel_bucket_i(int n) {
  if (n < 16) return n;
  return 16 + (n >= 22) + (n >= 30) + (n >= 40) + (n >= 54) + (n >= 73) + (n >= 99) + (n >= 134) + (n >= 182) + (n >= 246) + (n >= 332) + (n >= 450) + (n >= 609) + (n >= 825) + (n >= 1117) + (n >= 1513);
}

template <int MODE> DI void attn_unit(const Params& p, int b, int h, int qt, char* shm) {
  const int tid = opaque_tid(), lane = tid & 63, w = tid >> 6, r = lane & 31, hh = lane >> 5;
  const bf16_t* proj = (const bf16_t*)(p.ws + OFF_PROJ);
  const int qcol = (MODE == 0 ? 0 : 4096) + h * 128, kcol = qcol + 1024, vcol = qcol + 2048;
  const size_t tok0 = (size_t)b * SEQ;
  const int q0 = qt * 256, q0w = q0 + 32 * w, qpos = q0w + r;
  const float SC = 0.08838834764831845f * LOG2E;
  float* btab = (float*)(shm + AT_BT);
  int* flags = (int*)(shm + AT_FL);
  __syncthreads();
  bf16x8 qf[8];
  { const bf16_t* qp = proj + (tok0 + qpos) * PROJ_LD + qcol + 8 * hh;
#pragma unroll
    for (int s = 0; s < 8; ++s) qf[s] = *(const bf16x8*)(qp + 16 * s); }
  unsigned mymask = 0;
  if (MODE == 0) {
    float* kbl = (float*)(shm + AT_KB); unsigned* selm = (unsigned*)(shm + AT_SM);
    const float* kbg = (const float*)(p.ws + OFF_KBAR) + ((size_t)(b * 8 + h) * 16) * 128;
    *(f32x4*)(kbl + tid * 4) = *(const f32x4*)(kbg + tid * 4);
#pragma unroll
    for (int i = 0; i < 8; ++i) { const int d = tid + 512 * i; btab[d] = p.rel_bias[h * 32 + rel_bucket_i(d)] * LOG2E; }
    __syncthreads();
    const int ql = tid >> 1, half = tid & 1, own = qt;
    float g[8] = {0.f, 0.f, 0.f, 0.f, 0.f, 0.f, 0.f, 0.f};
    if (own > 0) {
      const bf16_t* qp = proj + (tok0 + q0 + ql) * PROJ_LD + qcol;
      for (int dc = 0; dc < 16; ++dc) {
        const u32x4 qv = *(const u32x4*)(qp + dc * 8);
        float qq[8];
#pragma unroll
        for (int e = 0; e < 4; ++e) { qq[2 * e] = bflo(qv[e]); qq[2 * e + 1] = bfhi(qv[e]); }
#pragma unroll
        for (int n = 0; n < 8; ++n) {
          const float* kr = kbl + (half * 8 + n) * 128 + dc * 8;
          const f32x4 k0 = *(const f32x4*)kr, k1 = *(const f32x4*)(kr + 4);
          g[n] += qq[0] * k0[0] + qq[1] * k0[1] + qq[2] * k0[2] + qq[3] * k0[3] + qq[4] * k1[0] + qq[5] * k1[1] + qq[6] * k1[2] + qq[7] * k1[3];
        }
      }
    }
    float all[16];
#pragma unroll
    for (int n = 0; n < 8; ++n) { const float go = __shfl_xor(g[n], 1); all[n] = half ? go : g[n]; all[8 + n] = half ? g[n] : go; }
    unsigned mask = 1u << own;
    const int nsel = own < 3 ? own : 3;
#pragma unroll
    for (int t = 0; t < 3; ++t) {
      if (t < nsel) {
        float best = -3.0e38f; int bi = 0;
#pragma unroll
        for (int n = 0; n < 16; ++n) { const bool ok = (n < own) && !((mask >> n) & 1u) && (all[n] > best); best = ok ? all[n] : best; bi = ok ? n : bi; }
        mask |= 1u << bi;
      }
    }
    if (half == 0) selm[ql] = mask;
    __syncthreads();
    mymask = selm[32 * w + r];
  } else {
    if (tid < 16) flags[tid] = 0;
  }
  bf16x8 tf[2];
  if (MODE == 1) {
#pragma unroll
    for (int s = 0; s < 2; ++s)
#pragma unroll
      for (int j = 0; j < 8; ++j) { const int k = 16 * s + 8 * (j >> 2) + 4 * hh + (j & 3); tf[s][j] = (k >= r) ? (short)0x3F80 : (short)0; }
  }
  f32x16 o[4];
#pragma unroll
  for (int dt = 0; dt < 4; ++dt)
#pragma unroll
    for (int i = 0; i < 16; ++i) o[dt][i] = 0.f;
  float mrun = -1e30f, lrun = 0.f, carry = 0.f;
  const int ntiles = 4 * qt + 4;
  u32x4 kreg[2], vreg[2];
#define GLOAD(kst) do { _Pragma("unroll") for (int _i = 0; _i < 2; ++_i) { const int _c = tid + 512 * _i, _key = _c >> 4, _part = _c & 15; \
      const bf16_t* _rp = proj + (tok0 + (kst) + _key) * PROJ_LD; kreg[_i] = *(const u32x4*)(_rp + kcol + _part * 8); vreg[_i] = *(const u32x4*)(_rp + vcol + _part * 8); } } while (0)
#define LSTORE(buf) do { _Pragma("unroll") for (int _i = 0; _i < 2; ++_i) { const int _c = tid + 512 * _i, _key = _c >> 4, _part = _c & 15; \
      *(u32x4*)(shm + (buf) * KBUF + _key * KP + _part * 16) = kreg[_i]; *(u32x4*)(shm + AT_V + (buf) * VBUF + _key * VP + _part * 16) = vreg[_i]; } } while (0)
#define KST(it) (MODE == 0 ? 64 * (it) : 64 * (ntiles - 1 - (it)))
  GLOAD(KST(0)); LSTORE(0); __syncthreads();
  const int i16 = lane & 15, q4 = i16 >> 2, p4 = i16 & 3, blk16 = (lane >> 4) & 1;
  bool wdone = false;
  for (int it = 0; it < ntiles; ++it) {
    const int buf = it & 1, kst = KST(it);
    if (MODE == 1 && it > 0) {
      const int* fl = flags + ((it - 1) & 1) * 8;
      const int alld = fl[0] & fl[1] & fl[2] & fl[3] & fl[4] & fl[5] & fl[6] & fl[7];
      if (alld) break;
    }
    if (it + 1 < ntiles) GLOAD(KST(it + 1));
    bool active;
    bool sel = true;
    if (MODE == 0) {
      const int j = kst >> 8;
      if (j == qt) active = (kst - q0) <= 32 * w + 31;
      else { sel = (mymask >> j) & 1u; active = __builtin_amdgcn_ballot_w64(sel) != 0ull; }
    } else {
      active = !wdone && (kst <= q0w + 31);
    }
    if (active) {
      f32x16 st[2];
#pragma unroll
      for (int sub = 0; sub < 2; ++sub) {
        f32x16 a16;
#pragma unroll
        for (int i = 0; i < 16; ++i) a16[i] = 0.f;
        const char* kb = shm + buf * KBUF + (sub * 32 + r) * KP + hh * 16;
#pragma unroll
        for (int s = 0; s < 8; ++s) a16 = mfma32(*(const bf16x8*)(kb + s * 32), qf[s], a16);
        st[sub] = a16;
      }
      if (MODE == 0) {
        float mx = -1e30f;
#pragma unroll
        for (int sub = 0; sub < 2; ++sub)
#pragma unroll
          for (int i = 0; i < 16; ++i) {
            const int key = kst + sub * 32 + (i & 3) + 8 * (i >> 2) + 4 * hh;
            const int dist = qpos - key;
            const bool valid = sel && (dist >= 0);
            const float bias = btab[dist < 0 ? 0 : dist];
            const float v = valid ? st[sub][i] * SC + bias : -1e30f;
            st[sub][i] = v; mx = fmaxf(mx, v);
          }
        mx = fmaxf(mx, __shfl_xor(mx, 32));
        const float mnew = fmaxf(mrun, mx), alpha = fexp2(mrun - mnew);
        mrun = mnew;
        float ps = 0.f;
#pragma unroll
        for (int sub = 0; sub < 2; ++sub)
#pragma unroll
          for (int i = 0; i < 16; ++i) { const float pv = fexp2(st[sub][i] - mnew); st[sub][i] = pv; ps += pv; }
        lrun = lrun * alpha + ps;
#pragma unroll
        for (int dt = 0; dt < 4; ++dt)
#pragma unroll
          for (int i = 0; i < 16; ++i) o[dt][i] *= alpha;
      } else {
#pragma unroll
        for (int sub = 1; sub >= 0; --sub) {
          f32x16 sp;
#pragma unroll
          for (int i = 0; i < 16; ++i) {
            const int key = kst + sub * 32 + (i & 3) + 8 * (i >> 2) + 4 * hh;
            const bool valid = key < qpos;
            const float z = st[sub][i] * SC;
            const float s = fmaxf(z, 0.f) + flog2(1.f + fexp2(-fabsf(z)));
            sp[i] = valid ? s : 0.f; st[sub][i] = z;
          }
          f32x16 c;
#pragma unroll
          for (int i = 0; i < 16; ++i) c[i] = carry;
#pragma unroll
          for (int s2 = 0; s2 < 2; ++s2) {
            u32x4 hi, lo;
#pragma unroll
            for (int jj = 0; jj < 4; ++jj) {
              const float a0 = sp[8 * s2 + 2 * jj], a1 = sp[8 * s2 + 2 * jj + 1];
              const unsigned hv = pk_bf16(a0, a1);
              hi[jj] = hv; lo[jj] = pk_bf16(a0 - bflo(hv), a1 - bfhi(hv));
            }
            c = mfma32(tf[s2], __builtin_bit_cast(bf16x8, hi), c);
            c = mfma32(tf[s2], __builtin_bit_cast(bf16x8, lo), c);
          }
          carry = __shfl(c[0], r);
#pragma unroll
          for (int i = 0; i < 16; ++i) {
            const int key = kst + sub * 32 + (i & 3) + 8 * (i >> 2) + 4 * hh;
            const bool valid = key < qpos;
            st[sub][i] = valid ? fexp2(st[sub][i] - c[i]) : 0.f;
          }
        }
        wdone = __builtin_amdgcn_ballot_w64(carry > 152.f) == ~0ull;
      }
      bf16x8 pf[4];
#pragma unroll
      for (int ks = 0; ks < 4; ++ks) {
        u32x4 t;
#pragma unroll
        for (int jj = 0; jj < 4; ++jj) t[jj] = pk_bf16(st[ks >> 1][8 * (ks & 1) + 2 * jj], st[ks >> 1][8 * (ks & 1) + 2 * jj + 1]);
        pf[ks] = __builtin_bit_cast(bf16x8, t);
      }
      const char* vb0 = shm + AT_V + buf * VBUF + (4 * hh + q4) * VP + 32 * blk16 + 8 * p4;
#pragma unroll
      for (int dt = 0; dt < 4; ++dt)
#pragma unroll
        for (int ks = 0; ks < 4; ++ks) {
          const char* vb = vb0 + (ks * 16) * VP + dt * 64;
          const s16x4 lo = __builtin_amdgcn_ds_read_tr16_b64_v4i16((LAS s16x4*)(vb));
          const s16x4 hi = __builtin_amdgcn_ds_read_tr16_b64_v4i16((LAS s16x4*)(vb + 8 * VP));
          o[dt] = mfma32(__builtin_shufflevector(lo, hi, 0, 1, 2, 3, 4, 5, 6, 7), pf[ks], o[dt]);
        }
    }
    if (MODE == 1) { if (lane == 0) flags[(it & 1) * 8 + w] = (wdone || (kst == 0)) ? 1 : 0; }
    if (it + 1 < ntiles) LSTORE(buf ^ 1);
    __syncthreads();
  }
  float inv = 1.f;
  if (MODE == 0) { const float lt = lrun + __shfl_xor(lrun, 32); inv = 1.f / lt; }
  bf16_t* yp = (bf16_t*)(p.ws + OFF_Y) + (tok0 + qpos) * Y_LD + (MODE == 0 ? 0 : 2048) + h * 128 + 4 * hh;
#pragma unroll
  for (int dt = 0; dt < 4; ++dt)
#pragma unroll
    for (int g = 0; g < 4; ++g) {
      u32x2 ov; ov[0] = pk_bf16(o[dt][4 * g] * inv, o[dt][4 * g + 1] * inv); ov[1] = pk_bf16(o[dt][4 * g + 2] * inv, o[dt][4 * g + 3] * inv);
      *(u32x2*)(yp + dt * 32 + 8 * g) = ov;
    }
#undef GLOAD
#undef LSTORE
#undef KST
}

DI void attention_phase(const Params& p, char* shm) {
  for (int k = blockIdx.x; k < 256; k += gridDim.x)
    for (int s = 0; s < 2; ++s) { const int u = s ? 511 - k : k; attn_unit<0>(p, (u & 31) >> 3, u & 7, 15 - (u >> 5), shm); }
  for (int k = blockIdx.x; k < 256; k += gridDim.x)
    for (int s = 0; s < 2; ++s) { const int u = s ? 511 - k : k; attn_unit<1>(p, (u & 31) >> 3, u & 7, 15 - (u >> 5), shm); }
}

constexpr int NPHASE = 17;
DI void run_phase(const Params& p, int ph, char* shm) {
  char* ws = p.ws;
  const int l = ph == 0 ? 0 : (ph - 1) >> 3, sp = ph == 0 ? -1 : (ph - 1) & 7;
  if (ph == 0 || (sp == 7 && l == 0)) { convert_layer(p, ph == 0 ? 0 : 1, shm); if (ph == 0) x_prep(p); return; }
  if (sp == 7) { final_norm(p); return; }
  if (sp == 1) { kbar_pool_phase(p, shm); return; }
  if (sp == 2) attention_phase(p, shm);
  const bf16_t* A; const bf16_t* Bt; int lda, ldb, K, nN, kind, nsub = 1, acs = 0, oc0 = 0, ocs = 256; const float* hin = nullptr;
  size_t asub = 0, bsub = 0;
  if (sp == 0) { A = (const bf16_t*)(ws + OFF_XB); lda = DM; Bt = (const bf16_t*)(ws + OFF_WIN); ldb = DM; K = DM; nN = 52; kind = EPI_IN; }
  else if (sp == 2) { A = (const bf16_t*)(ws + OFF_P); lda = 1024; Bt = (const bf16_t*)(ws + OFF_WPOOL); ldb = 256; K = 256; nN = 4; kind = EPI_POOL; acs = 256; oc0 = 1024; }
  else if (sp == 3) { A = (const bf16_t*)(ws + OFF_Y); lda = Y_LD; Bt = (const bf16_t*)(ws + OFF_WBR); ldb = 1024; K = 1024; nN = 8; kind = EPI_BR; nsub = 3; asub = 1024; bsub = SZ_WBR1 / 2; }
  else if (sp == 4) { A = (const bf16_t*)(ws + OFF_PROJ); lda = DM; Bt = (const bf16_t*)(ws + OFF_WOUT); ldb = DM; K = DM; nN = 8; kind = EPI_RES; hin = (l == 0 ? p.x : p.out); }
  else if (sp == 5) { A = (const bf16_t*)(ws + OFF_XB); lda = DM; Bt = (const bf16_t*)(ws + OFF_WGU); ldb = DM; K = DM; nN = 44; kind = EPI_FFN1; ocs = 128; }
  else { A = (const bf16_t*)(ws + OFF_PROJ); lda = DFF; Bt = (const bf16_t*)(ws + OFF_WDOWN); ldb = DFF; K = DFF; nN = 8; kind = EPI_RES; hin = p.out; }
  int pm, pn;
  for (int i = 0; tile_order(i * gridDim.x + blockIdx.x, 64, nN, pm, pn); ++i)
    for (int sub = 0; sub < nsub; ++sub)
      gemm_unit(p, A + sub * asub + pn * acs, lda, Bt + sub * bsub, ldb, K, pm * 256, pn * 256, kind, oc0 + pn * ocs, sub, hin, shm);
}

constexpr int LDS_BYTES = GEMM_LDS + 1024;

__global__ void __launch_bounds__(512, 2) hybrid_megakernel(Params p) {
  extern __shared__ __attribute__((aligned(16))) char shm[];
  for (int ph = p.phase_lo; ph < p.phase_hi; ++ph) {
    if (ph > p.phase_lo) cg::this_grid().sync();
    run_phase(p, ph, shm);
  }
}

#ifndef SINGLE_LAUNCH
#define SINGLE_LAUNCH 0
#endif

extern "C" void kernel_launch(void* const* d_in, const int* in_sizes, int n_in, void* d_out, int out_size, void* d_ws, size_t ws_size, hipStream_t stream) {
  static int grid_blocks = 0;
  if (!grid_blocks) {
    hipFuncSetAttribute((const void*)hybrid_megakernel, hipFuncAttributeMaxDynamicSharedMemorySize, LDS_BYTES);
    int dev = 0, cus = 0, per_cu = 0;
    hipGetDevice(&dev);
    hipDeviceGetAttribute(&cus, hipDeviceAttributeMultiprocessorCount, dev);
    hipOccupancyMaxActiveBlocksPerMultiprocessor(&per_cu, hybrid_megakernel, 512, LDS_BYTES);
    if (per_cu < 1) per_cu = 1;
    grid_blocks = cus * per_cu;
    if (ws_size < WS_NEED) fprintf(stderr, "workspace too small: %zu < %zu\n", ws_size, (size_t)WS_NEED);
  }
  Params p{};
  p.x = (const float*)d_in[0]; p.norm_mix = (const float*)d_in[1]; p.norm_ffn = (const float*)d_in[2]; p.w_in = (const float*)d_in[3];
  p.w_pool = (const float*)d_in[4]; p.pool_scale = (const float*)d_in[5]; p.w_br_a = (const float*)d_in[6]; p.w_br_b = (const float*)d_in[7];
  p.w_br_c = (const float*)d_in[8]; p.w_out = (const float*)d_in[9]; p.w_gate = (const float*)d_in[10]; p.w_up = (const float*)d_in[11];
  p.w_down = (const float*)d_in[12]; p.rel_bias = (const float*)d_in[13]; p.norm_final = (const float*)d_in[14];
  p.out = (float*)d_out; p.ws = (char*)d_ws;
#if SINGLE_LAUNCH
  p.phase_lo = 0; p.phase_hi = NPHASE;
  void* args[] = {&p};
  hipError_t e = hipLaunchCooperativeKernel((const void*)hybrid_megakernel, dim3(grid_blocks), dim3(512), args, LDS_BYTES, stream);
  if (e != hipSuccess) fprintf(stderr, "cooperative launch failed: %s (grid %d)\n", hipGetErrorString(e), grid_blocks);
#else
  for (int ph = 0; ph < NPHASE; ++ph) {
    p.phase_lo = ph; p.phase_hi = ph + 1;
    hipLaunchKernelGGL(hybrid_megakernel, dim3(grid_blocks), dim3(512), LDS_BYTES, stream, p);
  }
#endif
}
```

```cpp
#include <hip/hip_runtime.h>
#include <hip/hip_cooperative_groups.h>
#include <cstdio>
namespace cg = cooperative_groups;
#ifndef REP_N
#define REP_N 1
#define REP_PH 0
#endif

#define LAS __attribute__((address_space(3)))
#define DI __device__ __forceinline__
typedef unsigned short bf16_t;
typedef short bf16x8 __attribute__((ext_vector_type(8)));
typedef short s16x4 __attribute__((ext_vector_type(4)));
typedef float f32x4 __attribute__((ext_vector_type(4)));
typedef float f32x16 __attribute__((ext_vector_type(16)));
typedef unsigned u32x4 __attribute__((ext_vector_type(4)));
typedef unsigned u32x2 __attribute__((ext_vector_type(2)));

constexpr int DM = 2048, NBATCH = 4, SEQ = 4096, MTOK = NBATCH * SEQ, INW = 13312, DFF = 5632;
constexpr int PAD = 128;
constexpr int PROJ_W = 7168, PROJ_LD = PROJ_W + PAD, GATE_LD = 6144 + PAD, Y_LD = 3072 + PAD, XB_LD = DM + PAD, M_LD = DM + PAD, ACT_LD = DFF + PAD, P_LD = 1024 + PAD;
constexpr float LOG2E = 1.4426950408889634f;

constexpr size_t SZ_WIN = (size_t)INW * DM * 2;
constexpr size_t SZ_WPOOL = (size_t)4 * 256 * 256 * 2;
constexpr size_t SZ_WBR1 = (size_t)DM * 1024 * 2;
constexpr size_t SZ_WOUT = (size_t)DM * DM * 2;
constexpr size_t SZ_WGU = (size_t)2 * DFF * DM * 2;
constexpr size_t SZ_WDOWN = (size_t)DM * DFF * 2;
constexpr size_t OFF_WIN = 0;
constexpr size_t OFF_WPOOL = OFF_WIN + SZ_WIN;
constexpr size_t OFF_WBR = OFF_WPOOL + SZ_WPOOL;
constexpr size_t OFF_WOUT = OFF_WBR + 3 * SZ_WBR1;
constexpr size_t OFF_WGU = OFF_WOUT + SZ_WOUT;
constexpr size_t OFF_WDOWN = OFF_WGU + SZ_WGU;
constexpr size_t OFF_PROJ = OFF_WDOWN + SZ_WDOWN;
constexpr size_t OFF_GATES = OFF_PROJ + (size_t)MTOK * PROJ_LD * 2;
constexpr size_t OFF_XB = OFF_GATES + (size_t)MTOK * GATE_LD * 2;
constexpr size_t OFF_Y = OFF_XB + (size_t)MTOK * XB_LD * 2;
constexpr size_t OFF_P = OFF_Y + (size_t)MTOK * Y_LD * 2;
constexpr size_t OFF_SSQ = OFF_P + (size_t)MTOK * P_LD * 2;
constexpr size_t OFF_KBAR = OFF_SSQ + (size_t)MTOK * 32 * 4;
constexpr size_t OFF_BAR = OFF_KBAR + (size_t)4 * 16 * 2 * 1024 * 4;
constexpr size_t WS_NEED = OFF_BAR + 16384;

struct Params {
  const float *x, *norm_mix, *norm_ffn, *w_in, *w_pool, *pool_scale, *w_br_a, *w_br_b, *w_br_c, *w_out, *w_gate, *w_up, *w_down, *rel_bias, *norm_final;
  float* out;
  char* ws;
  int phase_lo, phase_hi;
};
typedef const __attribute__((address_space(4))) Params* KParams;

DI const char* uni_ptr(const char* q) { const unsigned long long v = (unsigned long long)q; const unsigned lo = __builtin_amdgcn_readfirstlane((unsigned)v), hi = __builtin_amdgcn_readfirstlane((unsigned)(v >> 32)); return (const char*)(((unsigned long long)hi << 32) | lo); }
DI int opaque_tid() { int t = threadIdx.x; asm volatile("" : "+v"(t)); return t; }
DI unsigned pk_bf16(float lo, float hi) { unsigned r; asm("v_cvt_pk_bf16_f32 %0, %1, %2" : "=v"(r) : "v"(lo), "v"(hi)); return r; }
DI float bflo(unsigned v) { return __uint_as_float(v << 16); }
DI float bfhi(unsigned v) { return __uint_as_float(v & 0xffff0000u); }
DI float fexp2(float x) { return __builtin_amdgcn_exp2f(x); }
DI float flog2(float x) { return __builtin_amdgcn_logf(x); }
DI f32x16 mfma32(bf16x8 a, bf16x8 b, f32x16 c) { return __builtin_amdgcn_mfma_f32_32x32x16_bf16(a, b, c, 0, 0, 0); }


#define XB_TMO      128
#define XB_XCNT(j)  (256  + 64 * (j))
#define XB_XSUB(j)  (1280 + 64 * (j))
#define XB_XGEN(j)  (2304 + 64 * (j))
#define XB_TOP      3328
#define XB_TOPGEN   3392
#define XCD_BAR_WORDS 3456
#define XB_SPIN_CAP (1u << 18)
DI unsigned xb_ld(unsigned* q) { return __hip_atomic_load(q, __ATOMIC_RELAXED, __HIP_MEMORY_SCOPE_AGENT); }
DI unsigned xb_add(unsigned* q, unsigned v) { return __hip_atomic_fetch_add(q, v, __ATOMIC_RELAXED, __HIP_MEMORY_SCOPE_AGENT); }
DI unsigned xb_xcc_id() { return (unsigned)__builtin_amdgcn_s_getreg((3 << 11) | 20) & 0xFu; }
#define XB_SPIN(cond, bar) do { unsigned _sp = 0; while (cond) { __builtin_amdgcn_s_sleep(1); \
    if ((++_sp & 255u) == 0u) { if (xb_ld(&(bar)[XB_TMO])) break; if (_sp > XB_SPIN_CAP) { atomicAdd(&(bar)[XB_TMO], 1u); break; } } } } while (0)
struct XcdBarrier { unsigned* bar; unsigned x; volatile LAS unsigned* st; };
DI XcdBarrier xcd_barrier_post(unsigned* bar, volatile LAS unsigned* st) {
  XcdBarrier b; b.bar = bar; b.x = xb_xcc_id(); b.st = st;
  if (threadIdx.x == 0) (void)xb_add(&bar[XB_XCNT(b.x)], 1u);
  return b;
}
DI void xcd_barrier_complete(unsigned* bar, unsigned x, unsigned& nloc, unsigned& nx) {
  const unsigned G = gridDim.x * gridDim.y * gridDim.z;
  unsigned sum, cnt, mine, sp = 0u;
  for (;;) {
    sum = 0u; cnt = 0u; mine = 0u;
#pragma unroll
    for (unsigned j = 0; j < 16; ++j) { const unsigned c = xb_ld(&bar[XB_XCNT(j)]); sum += c; cnt += (c > 0u) ? 1u : 0u; mine = (j == x) ? c : mine; }
    if (sum == G) break;
    __builtin_amdgcn_s_sleep(1);
    if ((++sp & 255u) == 0u) { if (xb_ld(&bar[XB_TMO])) break; if (sp > XB_SPIN_CAP) { atomicAdd(&bar[XB_TMO], 1u); break; } }
  }
  nloc = mine > 0u ? mine : 1u; nx = cnt > 0u ? cnt : 1u;
}
DI void xcd_barrier(const XcdBarrier& b, unsigned* bar_in) {
  asm volatile("s_waitcnt vmcnt(0)" ::: "memory");
  __syncthreads();
  if (threadIdx.x == 0) {
    unsigned* bar = bar_in;
    __builtin_amdgcn_s_waitcnt(0);
    unsigned nloc = b.st[0], nx = b.st[1];
    if (nloc == 0u) { xcd_barrier_complete(bar, b.x, nloc, nx); b.st[0] = nloc; b.st[1] = nx; }
    const unsigned old = xb_add(&bar[XB_XSUB(b.x)], 1u);
    const unsigned gen = old / nloc;
    if (old + 1u == (gen + 1u) * nloc) {
      __builtin_amdgcn_fence(__ATOMIC_RELEASE, "agent");
      asm volatile("s_waitcnt vmcnt(0)" ::: "memory");
      const unsigned og = xb_add(&bar[XB_TOP], 1u);
      const unsigned tg = og / nx;
      if (og + 1u == (tg + 1u) * nx) xb_add(&bar[XB_TOPGEN], 1u);
      else XB_SPIN(xb_ld(&bar[XB_TOPGEN]) == tg, bar);
      __builtin_amdgcn_fence(__ATOMIC_ACQUIRE, "agent");
      xb_add(&bar[XB_XGEN(b.x)], 1u);
      asm volatile("s_waitcnt vmcnt(0)" ::: "memory");
    } else {
      XB_SPIN(xb_ld(&bar[XB_XGEN(b.x)]) == gen, bar);
      __builtin_amdgcn_fence(__ATOMIC_ACQUIRE, "agent");
      asm volatile("s_waitcnt vmcnt(0)" ::: "memory");
    }
  }
  __syncthreads();
}

struct CvtTile { const float* src; bf16_t* dst; const float* rs; const float* cs; int K, N, blk, bs, off, kt, nt; };
constexpr int CVT_T0 = 32 * 52, CVT_T1 = CVT_T0 + 16, CVT_T2 = CVT_T1 + 3 * 128, CVT_T3 = CVT_T2 + 256, CVT_T4 = CVT_T3 + 2 * 704, CVT_TOTAL = CVT_T4 + 704;
DI CvtTile cvt_tile(KParams p, int l, int t) {
  char* ws = p->ws; CvtTile c; c.rs = nullptr; c.cs = nullptr; c.bs = 0; c.off = 0;
  int tt;
  if (t < CVT_T0) { tt = t; c.src = p->w_in + (size_t)l * DM * INW; c.dst = (bf16_t*)(ws + OFF_WIN); c.K = DM; c.N = INW; c.blk = INW; c.rs = p->norm_mix + l * DM; }
  else if (t < CVT_T1) { const int g = (t - CVT_T0) >> 2; tt = (t - CVT_T0) & 3; c.src = p->w_pool + ((size_t)l * 4 + g) * 65536; c.dst = (bf16_t*)(ws + OFF_WPOOL) + g * 65536; c.K = 256; c.N = 256; c.blk = 256; c.cs = p->pool_scale + l * 1024 + g * 256; }
  else if (t < CVT_T2) { const int b = (t - CVT_T1) >> 7; tt = (t - CVT_T1) & 127; const float* wa = p->w_br_a; const float* wb = p->w_br_b; const float* wc3 = p->w_br_c; asm volatile("" : "+s"(wa), "+s"(wb), "+s"(wc3)); c.src = (b == 0 ? wa : b == 1 ? wb : wc3) + (size_t)l * 1024 * DM; c.dst = (bf16_t*)(ws + OFF_WBR + b * SZ_WBR1); c.K = 1024; c.N = DM; c.blk = DM; }
  else if (t < CVT_T3) { tt = t - CVT_T2; c.src = p->w_out + (size_t)l * DM * DM; c.dst = (bf16_t*)(ws + OFF_WOUT); c.K = DM; c.N = DM; c.blk = DM; }
  else if (t < CVT_T4) { const int u = (t - CVT_T3) >= 704; tt = (t - CVT_T3) - u * 704; const float* wg = p->w_gate; const float* wu = p->w_up; asm volatile("" : "+s"(wg), "+s"(wu)); c.src = (u ? wu : wg) + (size_t)l * DM * DFF; c.dst = (bf16_t*)(ws + OFF_WGU); c.K = DM; c.N = DFF; c.blk = 128; c.bs = 256; c.off = u * 128; c.rs = p->norm_ffn + l * DM; }
  else { tt = t - CVT_T4; c.src = p->w_down + (size_t)l * DFF * DM; c.dst = (bf16_t*)(ws + OFF_WDOWN); c.K = DFF; c.N = DM; c.blk = DM; }
  const int ntn = c.N >> 8; c.kt = tt / ntn; c.nt = tt - c.kt * ntn;
  return c;
}

DI void convert_layer(KParams p, int l, char* shm) {
  float* tile = (float*)shm;
  const int tid = opaque_tid(), lane = tid & 63, w = tid >> 6;
  f32x4 v[8];
#define CVT_LOAD(tt) do { const CvtTile _c = cvt_tile(p, l, (tt)); \
    _Pragma("unroll") for (int i = 0; i < 8; ++i) { const int idx = tid + 512 * i, k = idx >> 6, n4 = idx & 63; v[i] = *(const f32x4*)(_c.src + (size_t)(_c.kt * 64 + k) * _c.N + _c.nt * 256 + 4 * n4); } } while (0)
  if ((int)blockIdx.x < CVT_TOTAL) CVT_LOAD(blockIdx.x);
  for (int t = blockIdx.x; t < CVT_TOTAL; t += gridDim.x) {
    const CvtTile c = cvt_tile(p, l, t);
    const int k0 = c.kt * 64, n0 = c.nt * 256;
    __syncthreads();
#pragma unroll
    for (int i = 0; i < 8; ++i) { const int idx = tid + 512 * i, k = idx >> 6, n4 = idx & 63; *(f32x4*)(tile + k * 256 + 4 * (n4 ^ ((k >> 3) & 7))) = v[i]; }
    __syncthreads();
    if (t + (int)gridDim.x < CVT_TOTAL) CVT_LOAD(t + gridDim.x);
    const int kc = lane >> 3;
    f32x4 g0 = {1.f, 1.f, 1.f, 1.f}, g1 = g0;
    if (c.rs) { g0 = *(const f32x4*)(c.rs + k0 + kc * 8); g1 = *(const f32x4*)(c.rs + k0 + kc * 8 + 4); }
#pragma unroll
    for (int pass = 0; pass < 4; ++pass) {
      const int n = 32 * w + 8 * pass + (lane & 7);
      float f[8];
#pragma unroll
      for (int j = 0; j < 8; ++j) f[j] = tile[(kc * 8 + j) * 256 + 4 * ((n >> 2) ^ kc) + (n & 3)];
      const int ng = n0 + n;
      const float cc = c.cs ? c.cs[ng] : 1.f;
      u32x4 o;
      o[0] = pk_bf16(f[0] * g0[0] * cc, f[1] * g0[1] * cc); o[1] = pk_bf16(f[2] * g0[2] * cc, f[3] * g0[3] * cc);
      o[2] = pk_bf16(f[4] * g1[0] * cc, f[5] * g1[1] * cc); o[3] = pk_bf16(f[6] * g1[2] * cc, f[7] * g1[3] * cc);
      const int q = ng / c.blk, dr0 = q * c.bs + c.off + (ng - q * c.blk);
      const int c32 = dr0 & 31, drow = (dr0 & ~31) + 16 * ((c32 >> 2) & 1) + 4 * (c32 >> 3) + (c32 & 3);
      *(u32x4*)(c.dst + (size_t)drow * c.K + k0 + kc * 8) = o;
    }
  }
#undef CVT_LOAD
}

DI void x_prep(KParams p) {
  const int tid = opaque_tid(), lane = tid & 63, w = tid >> 6;
  bf16_t* xb = (bf16_t*)(p->ws + OFF_XB); float* ssq = (float*)(p->ws + OFF_SSQ);
  const float* x = p->x;
  for (int row = blockIdx.x * 8 + w; row < MTOK; row += gridDim.x * 16) {
    const int row2 = row + gridDim.x * 8;
    const bool has2 = row2 < MTOK;
    f32x4 va[8], vb[8];
#pragma unroll
    for (int i = 0; i < 8; ++i) { const int c = (i * 64 + lane) * 4; va[i] = *(const f32x4*)(x + (size_t)row * DM + c); vb[i] = has2 ? *(const f32x4*)(x + (size_t)row2 * DM + c) : (f32x4){0.f, 0.f, 0.f, 0.f}; }
    float s0 = 0.f, s1 = 0.f;
#pragma unroll
    for (int i = 0; i < 8; ++i) {
      const int c = (i * 64 + lane) * 4;
      s0 += va[i][0] * va[i][0] + va[i][1] * va[i][1] + va[i][2] * va[i][2] + va[i][3] * va[i][3];
      s1 += vb[i][0] * vb[i][0] + vb[i][1] * vb[i][1] + vb[i][2] * vb[i][2] + vb[i][3] * vb[i][3];
      u32x2 o; o[0] = pk_bf16(va[i][0], va[i][1]); o[1] = pk_bf16(va[i][2], va[i][3]);
      *(u32x2*)(xb + (size_t)row * XB_LD + c) = o;
      if (has2) { u32x2 o2; o2[0] = pk_bf16(vb[i][0], vb[i][1]); o2[1] = pk_bf16(vb[i][2], vb[i][3]); *(u32x2*)(xb + (size_t)row2 * XB_LD + c) = o2; }
    }
    s0 += __shfl_xor(s0, 32); s1 += __shfl_xor(s1, 32);
    if (lane < 32) { ssq[(size_t)row * 32 + lane] = s0; if (has2) ssq[(size_t)row2 * 32 + lane] = s1; }
  }
}

DI void final_norm(KParams p) {
  const int tid = opaque_tid(), lane = tid & 63, w = tid >> 6;
  const float* ssq = (const float*)(p->ws + OFF_SSQ);
  const bf16_t* xb = (const bf16_t*)(p->ws + OFF_XB);
  float* out = p->out;
  f32x4 g[4][2];
#pragma unroll
  for (int i = 0; i < 4; ++i) { g[i][0] = *(const f32x4*)(p->norm_final + (i * 64 + lane) * 8); g[i][1] = *(const f32x4*)(p->norm_final + (i * 64 + lane) * 8 + 4); }
  for (int row = blockIdx.x * 8 + w; row < MTOK; row += gridDim.x * 16) {
    const int row2 = row + gridDim.x * 8;
    const bool has2 = row2 < MTOK;
    float s0 = (lane < 32) ? ssq[(size_t)row * 32 + lane] : 0.f, s1 = (lane < 32 && has2) ? ssq[(size_t)row2 * 32 + lane] : 0.f;
    u32x4 va[4], vb[4];
#pragma unroll
    for (int i = 0; i < 4; ++i) { const int c = (i * 64 + lane) * 8; va[i] = *(const u32x4*)(xb + (size_t)row * XB_LD + c); vb[i] = has2 ? *(const u32x4*)(xb + (size_t)row2 * XB_LD + c) : (u32x4){0u, 0u, 0u, 0u}; }
#pragma unroll
    for (int o = 32; o >= 1; o >>= 1) { s0 += __shfl_xor(s0, o); s1 += __shfl_xor(s1, o); }
    const float r0 = rsqrtf(s0 * (1.f / DM) + 1e-6f), r1 = rsqrtf(s1 * (1.f / DM) + 1e-6f);
#pragma unroll
    for (int i = 0; i < 4; ++i) {
      const int c = (i * 64 + lane) * 8;
      f32x4 a, b;
      a[0] = bflo(va[i][0]) * r0 * g[i][0][0]; a[1] = bfhi(va[i][0]) * r0 * g[i][0][1]; a[2] = bflo(va[i][1]) * r0 * g[i][0][2]; a[3] = bfhi(va[i][1]) * r0 * g[i][0][3];
      b[0] = bflo(va[i][2]) * r0 * g[i][1][0]; b[1] = bfhi(va[i][2]) * r0 * g[i][1][1]; b[2] = bflo(va[i][3]) * r0 * g[i][1][2]; b[3] = bfhi(va[i][3]) * r0 * g[i][1][3];
      *(f32x4*)(out + (size_t)row * DM + c) = a; *(f32x4*)(out + (size_t)row * DM + c + 4) = b;
      if (has2) {
        a[0] = bflo(vb[i][0]) * r1 * g[i][0][0]; a[1] = bfhi(vb[i][0]) * r1 * g[i][0][1]; a[2] = bflo(vb[i][1]) * r1 * g[i][0][2]; a[3] = bfhi(vb[i][1]) * r1 * g[i][0][3];
        b[0] = bflo(vb[i][2]) * r1 * g[i][1][0]; b[1] = bfhi(vb[i][2]) * r1 * g[i][1][1]; b[2] = bflo(vb[i][3]) * r1 * g[i][1][2]; b[3] = bfhi(vb[i][3]) * r1 * g[i][1][3];
        *(f32x4*)(out + (size_t)row2 * DM + c) = a; *(f32x4*)(out + (size_t)row2 * DM + c + 4) = b;
      }
    }
  }
}

DI void pool_tile(KParams p, int brow, int g) {
  const bf16_t* proj = (const bf16_t*)(p->ws + OFF_PROJ);
  bf16_t* P = (bf16_t*)(p->ws + OFF_P);
  const int tid = opaque_tid();
  const int win = 2 << g;
  for (int it = 0; it < 16; it += 2) {
    const int idx0 = it * 512 + tid, idx1 = idx0 + 512, c = g * 256 + (tid & 31) * 8;
    const int tok0 = brow + (idx0 >> 5), tok1 = brow + (idx1 >> 5);
    const int cnt0 = min(win, (tok0 & (SEQ - 1)) + 1), cnt1 = min(win, (tok1 & (SEQ - 1)) + 1);
    const bf16_t* up0 = proj + (size_t)tok0 * PROJ_LD + 3072 + c;
    const bf16_t* up1 = proj + (size_t)tok1 * PROJ_LD + 3072 + c;
    u32x4 ua[16], ub[16];
#pragma unroll
    for (int j = 0; j < 16; ++j) {
      ua[j] = (j < cnt0) ? *(const u32x4*)(up0 - (size_t)j * PROJ_LD) : (u32x4){0u, 0u, 0u, 0u};
      ub[j] = (j < cnt1) ? *(const u32x4*)(up1 - (size_t)j * PROJ_LD) : (u32x4){0u, 0u, 0u, 0u};
    }
    float a0[8] = {0.f, 0.f, 0.f, 0.f, 0.f, 0.f, 0.f, 0.f}, a1[8] = {0.f, 0.f, 0.f, 0.f, 0.f, 0.f, 0.f, 0.f};
#pragma unroll
    for (int j = 0; j < 16; ++j) {
#pragma unroll
      for (int e = 0; e < 4; ++e) { a0[2 * e] += bflo(ua[j][e]); a0[2 * e + 1] += bfhi(ua[j][e]); a1[2 * e] += bflo(ub[j][e]); a1[2 * e + 1] += bfhi(ub[j][e]); }
    }
    const float i0 = 1.f / (float)cnt0, i1 = 1.f / (float)cnt1;
    u32x4 o0, o1;
#pragma unroll
    for (int e = 0; e < 4; ++e) {
      o0[e] = pk_bf16(a0[2 * e] * i0 - bflo(ua[0][e]), a0[2 * e + 1] * i0 - bfhi(ua[0][e]));
      o1[e] = pk_bf16(a1[2 * e] * i1 - bflo(ub[0][e]), a1[2 * e + 1] * i1 - bfhi(ub[0][e]));
    }
    *(u32x4*)(P + (size_t)tok0 * P_LD + c) = o0;
    *(u32x4*)(P + (size_t)tok1 * P_LD + c) = o1;
  }
}

constexpr int BK = 64, HALF = 128, HT = HALF * BK;
constexpr int GEMM_LDS = 8 * HT * 2;
constexpr int RS_OFF = GEMM_LDS;
enum { EPI_IN = 0, EPI_POOL = 1, EPI_BR = 2, EPI_RES = 3, EPI_FFN1 = 4 };

DI int lds_byte(int r, int c) { const int st = (r >> 4) * 2 + (c >> 5), rr = r & 15, cc = c & 31, ob = rr * 64 + cc * 2; return st * 1024 + (ob ^ (((ob >> 9) & 1) << 5)); }
DI void stage_rc(int b, int& R, int& C) { const int st = b / 1024, sb = b % 1024, swz = sb ^ (((sb >> 9) & 1) << 5); R = (st >> 1) * 16 + swz / 64; C = (st & 1) * 32 + (swz % 64) / 2; }

DI bool tile_order(int L, int nM, int nN, int& pm, int& pn) {
  const int nwg = nM * nN; if (L >= nwg) return false;
  int wgid = L; { const int q = nwg / 8, r = nwg % 8, xcd = wgid % 8, off = wgid / 8; wgid = (xcd < r ? xcd * (q + 1) : r * (q + 1) + (xcd - r) * q) + off; }
  const int nig = 8 * nN, gid = wgid / nig, fm = gid * 8, gsz = (nM - fm) < 8 ? (nM - fm) : 8;
  pm = fm + ((wgid % nig) % gsz); pn = (wgid % nig) / gsz; return true;
}

DI void gemm_phase(KParams p, const bf16_t* __restrict__ A, int lda, const bf16_t* __restrict__ Bt, int ldb, int K, int nN, int kind,
                   int nsub, size_t asub, size_t bsub, int acs, int oc0, int ocs, const float* hin, char* shmc) {
  LAS unsigned char* lds = (LAS unsigned char*)shmc;
  const int tid = opaque_tid();
  const int wid = __builtin_amdgcn_readfirstlane(tid >> 6), lane = tid & 63, wr = wid >> 2, wc = wid & 3, fr = lane & 15, fq = lane >> 4;
  unsigned voffA[2], voffB[2];
#pragma unroll
  for (int i = 0; i < 2; ++i) { int R, C; stage_rc(tid * 16 + i * 8192, R, C); voffA[i] = (unsigned)(R * lda + C) * 2u; voffB[i] = (unsigned)(R * ldb + C) * 2u; }
  const unsigned ldsw = (unsigned)wid * 1024u;
  const int aoff = lds_byte(wr * 64 + fr, fq * 8), boff = lds_byte(wc * 32 + fr, fq * 8);
  const size_t hA = (size_t)HALF * lda * 2, hB = (size_t)HALF * ldb * 2;
#define SA(b, h) (((b) * 2 + (h)) * (HT * 2))
#define SB(b, h) ((4 + (b) * 2 + (h)) * (HT * 2))
#define STAGE(bufoff, gbase, voff) do { const char* _gb = uni_ptr(gbase); _Pragma("unroll") for (int _i = 0; _i < 2; ++_i) { unsigned _vo = (voff)[_i]; asm volatile("" : "+v"(_vo)); \
    __builtin_amdgcn_global_load_lds((const unsigned*)(_gb + _vo), (LAS unsigned*)(lds + (bufoff) + ldsw + _i * 8192), 16, 0, 0); } } while (0)
#define STA(P, hf, kt) STAGE(P, cA + (hf) * hA + (size_t)(kt) * (BK * 2), voffA)
#define STB(P, hf, kt) STAGE(P, cB + (hf) * hB + (size_t)(kt) * (BK * 2), voffB)
#define ISSUE_PROLOGUE() do { STB(SB(0, 0), 0, 0); STA(SA(0, 0), 0, 0); STB(SB(0, 1), 1, 0); STA(SA(0, 1), 1, 0); \
    STB(SB(1, 0), 0, 1); STA(SA(1, 0), 0, 1); STB(SB(1, 1), 1, 1); } while (0)
#define LDA(dst, b, h) do { _Pragma("unroll") for (int m = 0; m < 4; ++m) _Pragma("unroll") for (int k = 0; k < 2; ++k) dst[m][k] = *(const LAS bf16x8*)(lds + SA(b, h) + aoff + m * 2048 + k * 1024); } while (0)
#define LDB(dst, b, h) do { _Pragma("unroll") for (int n = 0; n < 2; ++n) _Pragma("unroll") for (int k = 0; k < 2; ++k) dst[n][k] = *(const LAS bf16x8*)(lds + SB(b, h) + boff + n * 2048 + k * 1024); } while (0)
#define MMA(ai, bj, Af, Bf) do { __builtin_amdgcn_s_setprio(1); \
    _Pragma("unroll") for (int m = 0; m < 4; ++m) _Pragma("unroll") for (int n = 0; n < 2; ++n) _Pragma("unroll") for (int k = 0; k < 2; ++k) \
      acc[ai][bj][m][n] = __builtin_amdgcn_mfma_f32_16x16x32_bf16(Bf[n][k], Af[m][k], acc[ai][bj][m][n], 0, 0, 0); \
    __builtin_amdgcn_s_setprio(0); } while (0)
#define WAIT_V(n) asm volatile("s_waitcnt vmcnt(" #n ")" ::: "memory")
#define WAIT_L(n) asm volatile("s_waitcnt lgkmcnt(" #n ")" ::: "memory")
#define BAR __builtin_amdgcn_s_barrier()
#define SCHED __builtin_amdgcn_sched_barrier(0)

  int pm, pn, sub = 0, rnd = 0, rs_brow = -1;
  if (!tile_order(blockIdx.x, 64, nN, pm, pn)) return;
  const char* cA = (const char*)(A + pn * acs) + (size_t)pm * 256 * lda * 2;
  const char* cB = (const char*)Bt + (size_t)pn * 256 * ldb * 2;
  if (kind == EPI_POOL) {
    int qm, qn;
    for (int r2 = 0; tile_order(r2 * gridDim.x + blockIdx.x, 64, nN, qm, qn); ++r2) pool_tile(p, qm * 256, qn);
    asm volatile("s_waitcnt vmcnt(0)" ::: "memory");
  }
  __syncthreads();
  ISSUE_PROLOGUE();
  const int nt = K / BK;
  bool have = true;
  while (have) {
    const int brow = pm * 256, ocol = oc0 + pn * ocs, aux = sub;
    float* rsl = (float*)(shmc + RS_OFF);
    if ((kind == EPI_IN || kind == EPI_FFN1) && brow != rs_brow) {
      rs_brow = brow;
      __syncthreads();
      if (tid < 256) {
        const float* sp = (const float*)(p->ws + OFF_SSQ) + (size_t)(brow + tid) * 32;
        float s = 0.f;
#pragma unroll
        for (int i = 0; i < 8; ++i) { const f32x4 v = *(const f32x4*)(sp + 4 * i); s += (v[0] + v[1]) + (v[2] + v[3]); }
        rsl[tid] = rsqrtf(s * (1.f / DM) + 1e-6f);
      }
    }
    f32x4 acc[2][2][4][2];
#pragma unroll
    for (int a = 0; a < 2; ++a)
#pragma unroll
      for (int b = 0; b < 2; ++b)
#pragma unroll
        for (int m = 0; m < 4; ++m)
#pragma unroll
          for (int n = 0; n < 2; ++n) acc[a][b][m][n] = (f32x4){0.f, 0.f, 0.f, 0.f};
    bf16x8 At[4][2], B0[2][2], B1[2][2];
    if (wr == 1) BAR;
    WAIT_V(10); BAR;
    WAIT_V(6); BAR;
    for (int t = 0; t < nt - 2; t += 2) {
      LDB(B0, 0, 0); SCHED; LDA(At, 0, 0); STA(SA(1, 1), 1, t + 1);
      WAIT_L(8); BAR; WAIT_L(0); MMA(0, 0, At, B0); BAR; SCHED;
      LDB(B1, 0, 1); STB(SB(0, 0), 0, t + 2);
      BAR; WAIT_L(0); MMA(0, 1, At, B1); BAR;
      LDA(At, 0, 1); STA(SA(0, 0), 0, t + 2);
      BAR; WAIT_L(0); MMA(1, 0, At, B0); BAR; SCHED;
      STB(SB(0, 1), 1, t + 2);
      WAIT_V(6); BAR; MMA(1, 1, At, B1); BAR;
      LDB(B0, 1, 0); SCHED; LDA(At, 1, 0); STA(SA(0, 1), 1, t + 2);
      WAIT_L(8); BAR; WAIT_L(0); MMA(0, 0, At, B0); BAR; SCHED;
      LDB(B1, 1, 1); STB(SB(1, 0), 0, t + 3);
      BAR; WAIT_L(0); MMA(0, 1, At, B1); BAR;
      LDA(At, 1, 1); STA(SA(1, 0), 0, t + 3);
      BAR; WAIT_L(0); MMA(1, 0, At, B0); BAR; SCHED;
      STB(SB(1, 1), 1, t + 3);
      WAIT_V(6); BAR; MMA(1, 1, At, B1); BAR;
    }
    { LDB(B0, 0, 0); LDA(At, 0, 0); STA(SA(1, 1), 1, nt - 1);
      BAR; WAIT_L(0); MMA(0, 0, At, B0); BAR;
      LDB(B1, 0, 1); BAR; WAIT_L(0); MMA(0, 1, At, B1); BAR;
      LDA(At, 0, 1); WAIT_V(4); BAR; WAIT_L(0); MMA(1, 0, At, B0); MMA(1, 1, At, B1); BAR; }
    { LDB(B0, 1, 0); LDA(At, 1, 0); WAIT_V(2); BAR; WAIT_L(0); MMA(0, 0, At, B0); BAR;
      LDB(B1, 1, 1); WAIT_V(0); BAR; WAIT_L(0); MMA(0, 1, At, B1); BAR;
      LDA(At, 1, 1); BAR; WAIT_L(0); MMA(1, 0, At, B0); MMA(1, 1, At, B1); BAR; }
    if (wr == 0) BAR;
    {
      int pm2 = pm, pn2 = pn, sub2 = sub + 1;
      if (sub2 == nsub) { sub2 = 0; ++rnd; have = tile_order(rnd * gridDim.x + blockIdx.x, 64, nN, pm2, pn2); }
      if (have) {
        cA = (const char*)(A + sub2 * asub + pn2 * acs) + (size_t)pm2 * 256 * lda * 2;
        cB = (const char*)(Bt + sub2 * bsub) + (size_t)pn2 * 256 * ldb * 2;
        ISSUE_PROLOGUE();
      }
      pm = pm2; pn = pn2; sub = sub2;
    }
    char* ws = p->ws;
    int cl = wc * 32 + 8 * fq; asm volatile("" : "+v"(cl));
    int fr_e = fr; asm volatile("" : "+v"(fr_e));
    if (kind == EPI_IN) {
      const bool isgate = ocol >= PROJ_W;
      bf16_t* obase = isgate ? (bf16_t*)(ws + OFF_GATES) + (ocol - PROJ_W) : (bf16_t*)(ws + OFF_PROJ) + ocol;
      const int old = isgate ? GATE_LD : PROJ_LD;
#pragma unroll
      for (int ai = 0; ai < 2; ++ai)
#pragma unroll
        for (int m = 0; m < 4; ++m) {
          const int rl = ai * HALF + wr * 64 + m * 16 + fr_e;
          const float rs = rsl[rl];
          bf16_t* rowp = obase + (size_t)(brow + rl) * old + cl;
#pragma unroll
          for (int bj = 0; bj < 2; ++bj) {
            f32x4 v0 = acc[ai][bj][m][0] * rs, v1 = acc[ai][bj][m][1] * rs;
            if (isgate) {
#pragma unroll
              for (int j = 0; j < 4; ++j) { v0[j] = __builtin_amdgcn_rcpf(1.f + fexp2(-LOG2E * v0[j])); v1[j] = __builtin_amdgcn_rcpf(1.f + fexp2(-LOG2E * v1[j])); }
            }
            u32x4 o; o[0] = pk_bf16(v0[0], v0[1]); o[1] = pk_bf16(v0[2], v0[3]); o[2] = pk_bf16(v1[0], v1[1]); o[3] = pk_bf16(v1[2], v1[3]);
            *(u32x4*)(rowp + bj * HALF) = o;
          }
        }
      if (ocol >= 1024 && ocol < 2048) {
        float* kb2 = (float*)(ws + OFF_KBAR) + ((size_t)(brow >> 8) * 2 + wr) * 1024 + (ocol - 1024) + cl;
#pragma unroll
        for (int bj = 0; bj < 2; ++bj)
#pragma unroll
          for (int n = 0; n < 2; ++n) {
            f32x4 s = {0.f, 0.f, 0.f, 0.f};
#pragma unroll
            for (int ai = 0; ai < 2; ++ai)
#pragma unroll
              for (int m = 0; m < 4; ++m) s += acc[ai][bj][m][n] * rsl[ai * HALF + wr * 64 + m * 16 + fr_e];
#pragma unroll
            for (int j = 0; j < 4; ++j) { float t = s[j]; t += __shfl_xor(t, 1); t += __shfl_xor(t, 2); t += __shfl_xor(t, 4); t += __shfl_xor(t, 8); s[j] = t; }
            if (fr_e == 0) *(f32x4*)(kb2 + bj * HALF + 4 * n) = s;
          }
      }
    } else if (kind == EPI_POOL) {
      bf16_t* obase = (bf16_t*)(ws + OFF_Y) + ocol;
#pragma unroll
      for (int ai = 0; ai < 2; ++ai)
#pragma unroll
        for (int m = 0; m < 4; ++m) {
          const int rl = ai * HALF + wr * 64 + m * 16 + fr_e;
          bf16_t* rowp = obase + (size_t)(brow + rl) * Y_LD + cl;
#pragma unroll
          for (int bj = 0; bj < 2; ++bj) {
            const f32x4 v0 = acc[ai][bj][m][0], v1 = acc[ai][bj][m][1];
            u32x4 o; o[0] = pk_bf16(v0[0], v0[1]); o[1] = pk_bf16(v0[2], v0[3]); o[2] = pk_bf16(v1[0], v1[1]); o[3] = pk_bf16(v1[2], v1[3]);
            *(u32x4*)(rowp + bj * HALF) = o;
          }
        }
    } else if (kind == EPI_BR) {
      const bf16_t* gbase = (const bf16_t*)(ws + OFF_GATES) + aux * DM + ocol;
      bf16_t* mbase = (bf16_t*)(ws + OFF_PROJ) + ocol;
#pragma unroll
      for (int ai = 0; ai < 2; ++ai) {
        u32x4 gg[4][2], mm[4][2];
#pragma unroll
        for (int m = 0; m < 4; ++m) {
          const int rl = ai * HALF + wr * 64 + m * 16 + fr_e;
          const bf16_t* grow = gbase + (size_t)(brow + rl) * GATE_LD + cl;
          const bf16_t* mrow = mbase + (size_t)(brow + rl) * M_LD + cl;
#pragma unroll
          for (int bj = 0; bj < 2; ++bj) {
            gg[m][bj] = *(const u32x4*)(grow + bj * HALF);
            mm[m][bj] = (aux != 0) ? *(const u32x4*)(mrow + bj * HALF) : (u32x4){0u, 0u, 0u, 0u};
          }
        }
#pragma unroll
        for (int m = 0; m < 4; ++m) {
          const int rl = ai * HALF + wr * 64 + m * 16 + fr_e;
          bf16_t* mrow = mbase + (size_t)(brow + rl) * M_LD + cl;
#pragma unroll
          for (int bj = 0; bj < 2; ++bj) {
            const u32x4 g = gg[m][bj], mo = mm[m][bj];
            f32x4 v0 = acc[ai][bj][m][0], v1 = acc[ai][bj][m][1];
            v0[0] = v0[0] * bflo(g[0]) + bflo(mo[0]); v0[1] = v0[1] * bfhi(g[0]) + bfhi(mo[0]); v0[2] = v0[2] * bflo(g[1]) + bflo(mo[1]); v0[3] = v0[3] * bfhi(g[1]) + bfhi(mo[1]);
            v1[0] = v1[0] * bflo(g[2]) + bflo(mo[2]); v1[1] = v1[1] * bfhi(g[2]) + bfhi(mo[2]); v1[2] = v1[2] * bflo(g[3]) + bflo(mo[3]); v1[3] = v1[3] * bfhi(g[3]) + bfhi(mo[3]);
            u32x4 o; o[0] = pk_bf16(v0[0], v0[1]); o[1] = pk_bf16(v0[2], v0[3]); o[2] = pk_bf16(v1[0], v1[1]); o[3] = pk_bf16(v1[2], v1[3]);
            *(u32x4*)(mrow + bj * HALF) = o;
          }
        }
      }
    } else if (kind == EPI_RES) {
      bf16_t* xb = (bf16_t*)(ws + OFF_XB) + ocol;
      float* ssq = (float*)(ws + OFF_SSQ);
      const int pslot = (ocol >> 8) * 4 + wc;
#pragma unroll
      for (int ai = 0; ai < 2; ++ai) {
        u32x4 hh[4][2];
#pragma unroll
        for (int m = 0; m < 4; ++m) {
          const int rl = ai * HALF + wr * 64 + m * 16 + fr_e;
          const bf16_t* xr = xb + (size_t)(brow + rl) * XB_LD + cl;
#pragma unroll
          for (int bj = 0; bj < 2; ++bj) hh[m][bj] = *(const u32x4*)(xr + bj * HALF);
        }
#pragma unroll
        for (int m = 0; m < 4; ++m) {
          const int rl = ai * HALF + wr * 64 + m * 16 + fr_e;
          bf16_t* xr = xb + (size_t)(brow + rl) * XB_LD + cl;
          float s = 0.f;
#pragma unroll
          for (int bj = 0; bj < 2; ++bj) {
            const u32x4 h = hh[m][bj];
            f32x4 v0 = acc[ai][bj][m][0], v1 = acc[ai][bj][m][1];
            v0[0] += bflo(h[0]); v0[1] += bfhi(h[0]); v0[2] += bflo(h[1]); v0[3] += bfhi(h[1]);
            v1[0] += bflo(h[2]); v1[1] += bfhi(h[2]); v1[2] += bflo(h[3]); v1[3] += bfhi(h[3]);
            s += v0[0] * v0[0] + v0[1] * v0[1] + v0[2] * v0[2] + v0[3] * v0[3] + v1[0] * v1[0] + v1[1] * v1[1] + v1[2] * v1[2] + v1[3] * v1[3];
            u32x4 o; o[0] = pk_bf16(v0[0], v0[1]); o[1] = pk_bf16(v0[2], v0[3]); o[2] = pk_bf16(v1[0], v1[1]); o[3] = pk_bf16(v1[2], v1[3]);
            *(u32x4*)(xr + bj * HALF) = o;
          }
          s += __shfl_xor(s, 16); s += __shfl_xor(s, 32);
          if (fq == 0) ssq[(size_t)(brow + rl) * 32 + pslot] = s;
        }
      }
    } else {
      bf16_t* abase = (bf16_t*)(ws + OFF_PROJ) + ocol;
#pragma unroll
      for (int ai = 0; ai < 2; ++ai)
#pragma unroll
        for (int m = 0; m < 4; ++m) {
          const int rl = ai * HALF + wr * 64 + m * 16 + fr_e;
          const float rs = rsl[rl];
          bf16_t* rowp = abase + (size_t)(brow + rl) * ACT_LD + cl;
          f32x4 v[2];
#pragma unroll
          for (int n = 0; n < 2; ++n) {
            const f32x4 g = acc[ai][0][m][n] * rs, u = acc[ai][1][m][n] * rs;
#pragma unroll
            for (int j = 0; j < 4; ++j) v[n][j] = g[j] * __builtin_amdgcn_rcpf(1.f + fexp2(-LOG2E * g[j])) * u[j];
          }
          u32x4 o; o[0] = pk_bf16(v[0][0], v[0][1]); o[1] = pk_bf16(v[0][2], v[0][3]); o[2] = pk_bf16(v[1][0], v[1][1]); o[3] = pk_bf16(v[1][2], v[1][3]);
          *(u32x4*)rowp = o;
        }
    }
  }
}

DI void branch_phase(KParams p, char* shmc) {
  LAS unsigned char* lds = (LAS unsigned char*)shmc;
  const int tid = opaque_tid();
  const int wid = __builtin_amdgcn_readfirstlane(tid >> 6), lane = tid & 63, wr = wid >> 2, wc = wid & 3, fr = lane & 15, fq = lane >> 4;
  const int lda = Y_LD, ldb = 1024;
  unsigned voffA[2], voffB[2];
#pragma unroll
  for (int i = 0; i < 2; ++i) { int R, C; stage_rc(tid * 16 + i * 8192, R, C); voffA[i] = (unsigned)(R * lda + C) * 2u; voffB[i] = (unsigned)(R * ldb + C) * 2u; }
  const unsigned ldsw = (unsigned)wid * 1024u;
  const int aoff = lds_byte(wr * 64 + fr, fq * 8), boff = lds_byte(wc * 32 + fr, fq * 8);
  const size_t hA = (size_t)HALF * lda * 2, hB = (size_t)HALF * ldb * 2;
  char* ws = p->ws;
  const bf16_t* Y = (const bf16_t*)(ws + OFF_Y); const bf16_t* W = (const bf16_t*)(ws + OFF_WBR);
  int pm, pn, rnd = 0;
  if (!tile_order(blockIdx.x, 64, 8, pm, pn)) return;
  const char* cA = (const char*)Y + (size_t)pm * 256 * lda * 2;
  const char* cB = (const char*)W + (size_t)pn * 256 * ldb * 2;
  __syncthreads();
  ISSUE_PROLOGUE();
  const int nt = 16;
  bool have = true;
  while (have) {
    const int brow = pm * 256, ocol = pn * 256;
    int pm2 = pm, pn2 = pn;
    f32x4 acc[2][2][4][2];
#pragma unroll
    for (int a = 0; a < 2; ++a)
#pragma unroll
      for (int b = 0; b < 2; ++b)
#pragma unroll
        for (int m = 0; m < 4; ++m)
#pragma unroll
          for (int n = 0; n < 2; ++n) acc[a][b][m][n] = (f32x4){0.f, 0.f, 0.f, 0.f};
#pragma unroll 1
    for (int br = 0; br < 3; ++br) {
      bf16x8 At[4][2], B0[2][2], B1[2][2];
      if (wr == 1) BAR;
      WAIT_V(10); BAR;
      WAIT_V(6); BAR;
      for (int t = 0; t < nt - 2; t += 2) {
        LDB(B0, 0, 0); SCHED; LDA(At, 0, 0); STA(SA(1, 1), 1, t + 1);
        WAIT_L(8); BAR; WAIT_L(0); MMA(0, 0, At, B0); BAR; SCHED;
        LDB(B1, 0, 1); STB(SB(0, 0), 0, t + 2);
        BAR; WAIT_L(0); MMA(0, 1, At, B1); BAR;
        LDA(At, 0, 1); STA(SA(0, 0), 0, t + 2);
        BAR; WAIT_L(0); MMA(1, 0, At, B0); BAR; SCHED;
        STB(SB(0, 1), 1, t + 2);
        WAIT_V(6); BAR; MMA(1, 1, At, B1); BAR;
        LDB(B0, 1, 0); SCHED; LDA(At, 1, 0); STA(SA(0, 1), 1, t + 2);
        WAIT_L(8); BAR; WAIT_L(0); MMA(0, 0, At, B0); BAR; SCHED;
        LDB(B1, 1, 1); STB(SB(1, 0), 0, t + 3);
        BAR; WAIT_L(0); MMA(0, 1, At, B1); BAR;
        LDA(At, 1, 1); STA(SA(1, 0), 0, t + 3);
        BAR; WAIT_L(0); MMA(1, 0, At, B0); BAR; SCHED;
        STB(SB(1, 1), 1, t + 3);
        WAIT_V(6); BAR; MMA(1, 1, At, B1); BAR;
      }
      { LDB(B0, 0, 0); LDA(At, 0, 0); STA(SA(1, 1), 1, nt - 1);
        BAR; WAIT_L(0); MMA(0, 0, At, B0); BAR;
        LDB(B1, 0, 1); BAR; WAIT_L(0); MMA(0, 1, At, B1); BAR;
        LDA(At, 0, 1); WAIT_V(4); BAR; WAIT_L(0); MMA(1, 0, At, B0); MMA(1, 1, At, B1); BAR; }
      { LDB(B0, 1, 0); LDA(At, 1, 0); WAIT_V(2); BAR; WAIT_L(0); MMA(0, 0, At, B0); BAR;
        LDB(B1, 1, 1); WAIT_V(0); BAR; WAIT_L(0); MMA(0, 1, At, B1); BAR;
        LDA(At, 1, 1); BAR; WAIT_L(0); MMA(1, 0, At, B0); MMA(1, 1, At, B1); BAR; }
      if (wr == 0) BAR;
      if (br < 2) {
        cA = (const char*)(Y + (br + 1) * 1024) + (size_t)pm * 256 * lda * 2;
        cB = (const char*)(W + (size_t)(br + 1) * (SZ_WBR1 / 2)) + (size_t)pn * 256 * ldb * 2;
        ISSUE_PROLOGUE();
      } else {
        ++rnd; have = tile_order(rnd * gridDim.x + blockIdx.x, 64, 8, pm2, pn2);
        if (have) { cA = (const char*)Y + (size_t)pm2 * 256 * lda * 2; cB = (const char*)W + (size_t)pn2 * 256 * ldb * 2; ISSUE_PROLOGUE(); }
      }
      int lane2 = __builtin_amdgcn_mbcnt_hi(~0u, __builtin_amdgcn_mbcnt_lo(~0u, 0u)); asm volatile("" : "+v"(lane2));
      const int cl = wc * 32 + 8 * (lane2 >> 4), fr_e = lane2 & 15;
      const bf16_t* gcur = (const bf16_t*)(ws + OFF_GATES) + br * DM + ocol;
      const bf16_t* gnxt = gcur + DM;
      bf16_t* mbase = (bf16_t*)(ws + OFF_PROJ) + ocol;
#pragma unroll
      for (int ai = 0; ai < 2; ++ai)
#pragma unroll
        for (int mh = 0; mh < 2; ++mh) {
          u32x4 gg[2][2], gn[2][2];
#pragma unroll
          for (int m2 = 0; m2 < 2; ++m2) {
            const int rl = ai * HALF + wr * 64 + (mh * 2 + m2) * 16 + fr_e;
            const size_t go = (size_t)(brow + rl) * GATE_LD + cl;
#pragma unroll
            for (int bj = 0; bj < 2; ++bj) {
              gg[m2][bj] = *(const u32x4*)(gcur + go + bj * HALF);
              if (br < 2) gn[m2][bj] = *(const u32x4*)(gnxt + go + bj * HALF);
            }
          }
#pragma unroll
          for (int m2 = 0; m2 < 2; ++m2) {
            const int m = mh * 2 + m2;
            const int rl = ai * HALF + wr * 64 + m * 16 + fr_e;
            bf16_t* mrow = mbase + (size_t)(brow + rl) * M_LD + cl;
#pragma unroll
            for (int bj = 0; bj < 2; ++bj) {
              const u32x4 g = gg[m2][bj];
              f32x4 v0 = acc[ai][bj][m][0], v1 = acc[ai][bj][m][1];
              if (br < 2) {
                const u32x4 d = gn[m2][bj];
                v0[0] *= bflo(g[0]) * __builtin_amdgcn_rcpf(fmaxf(bflo(d[0]), 1e-20f)); v0[1] *= bfhi(g[0]) * __builtin_amdgcn_rcpf(fmaxf(bfhi(d[0]), 1e-20f));
                v0[2] *= bflo(g[1]) * __builtin_amdgcn_rcpf(fmaxf(bflo(d[1]), 1e-20f)); v0[3] *= bfhi(g[1]) * __builtin_amdgcn_rcpf(fmaxf(bfhi(d[1]), 1e-20f));
                v1[0] *= bflo(g[2]) * __builtin_amdgcn_rcpf(fmaxf(bflo(d[2]), 1e-20f)); v1[1] *= bfhi(g[2]) * __builtin_amdgcn_rcpf(fmaxf(bfhi(d[2]), 1e-20f));
                v1[2] *= bflo(g[3]) * __builtin_amdgcn_rcpf(fmaxf(bflo(d[3]), 1e-20f)); v1[3] *= bfhi(g[3]) * __builtin_amdgcn_rcpf(fmaxf(bfhi(d[3]), 1e-20f));
                acc[ai][bj][m][0] = v0; acc[ai][bj][m][1] = v1;
              } else {
                v0[0] *= fmaxf(bflo(g[0]), 1e-20f); v0[1] *= fmaxf(bfhi(g[0]), 1e-20f); v0[2] *= fmaxf(bflo(g[1]), 1e-20f); v0[3] *= fmaxf(bfhi(g[1]), 1e-20f);
                v1[0] *= fmaxf(bflo(g[2]), 1e-20f); v1[1] *= fmaxf(bfhi(g[2]), 1e-20f); v1[2] *= fmaxf(bflo(g[3]), 1e-20f); v1[3] *= fmaxf(bfhi(g[3]), 1e-20f);
                u32x4 o; o[0] = pk_bf16(v0[0], v0[1]); o[1] = pk_bf16(v0[2], v0[3]); o[2] = pk_bf16(v1[0], v1[1]); o[3] = pk_bf16(v1[2], v1[3]);
                *(u32x4*)(mrow + bj * HALF) = o;
              }
            }
          }
        }
    }
    pm = pm2; pn = pn2;
  }
}

constexpr int KP = 272, VP = 320, KBUF = 64 * KP, VBUF = 64 * VP;
constexpr int AT_V = 3 * KBUF, AT_BT = AT_V + 3 * VBUF, AT_KB = AT_BT + 16384, AT_SM = AT_KB + 8192, AT_FL = AT_SM + 1024;

DI int rel_bucket_i(int n) {
  if (n < 16) return n;
  return 16 + (n >= 22) + (n >= 30) + (n >= 40) + (n >= 54) + (n >= 73) + (n >= 99) + (n >= 134) + (n >= 182) + (n >= 246) + (n >= 332) + (n >= 450) + (n >= 609) + (n >= 825) + (n >= 1117) + (n >= 1513);
}

template <int MODE> DI void attn_unit(KParams p, int b, int h, int qt, char* shm) {
  const int tid = opaque_tid(), lane = tid & 63, w = __builtin_amdgcn_readfirstlane(tid >> 6), r = lane & 31, hh = lane >> 5;
  const bf16_t* proj = (const bf16_t*)(p->ws + OFF_PROJ);
  const int qcol = (MODE == 0 ? 0 : 4096) + h * 128, kcol = qcol + 1024, vcol = qcol + 2048;
  const size_t tok0 = (size_t)b * SEQ;
  const int q0 = qt * 256, q0w = q0 + 32 * w, qpos = q0w + r;
  const float SC = 0.08838834764831845f * LOG2E;
  float* btab = (float*)(shm + AT_BT);
  int* flags = (int*)(shm + AT_FL);
  __syncthreads();
  bf16x8 qf[8];
  { const bf16_t* qp = proj + (tok0 + qpos) * PROJ_LD + qcol + 8 * hh;
#pragma unroll
    for (int s = 0; s < 8; ++s) qf[s] = *(const bf16x8*)(qp + 16 * s); }
  unsigned mymask = 0;
  if (MODE == 0) {
    float* kbl = (float*)(shm + AT_KB); unsigned* selm = (unsigned*)(shm + AT_SM);
    { const int kblk = tid >> 5, part = tid & 31;
      const float* kbg = (const float*)(p->ws + OFF_KBAR) + ((size_t)(b * 16 + kblk) * 2) * 1024 + h * 128 + part * 4;
      const f32x4 k0 = *(const f32x4*)kbg, k1 = *(const f32x4*)(kbg + 1024);
      *(f32x4*)(kbl + kblk * 128 + part * 4) = (k0 + k1) * (1.f / 256.f); }
#pragma unroll
    for (int i = 0; i < 8; ++i) { const int d = tid + 512 * i; btab[d] = p->rel_bias[h * 32 + rel_bucket_i(d)] * LOG2E; }
    __syncthreads();
    const int ql = tid >> 1, half = tid & 1, own = qt;
    float g[8] = {0.f, 0.f, 0.f, 0.f, 0.f, 0.f, 0.f, 0.f};
    if (own > 0) {
      const bf16_t* qp = proj + (tok0 + q0 + ql) * PROJ_LD + qcol;
#pragma unroll 2
      for (int dc = 0; dc < 16; ++dc) {
        const u32x4 qv = *(const u32x4*)(qp + dc * 8);
        float qq[8];
#pragma unroll
        for (int e = 0; e < 4; ++e) { qq[2 * e] = bflo(qv[e]); qq[2 * e + 1] = bfhi(qv[e]); }
#pragma unroll
        for (int n = 0; n < 8; ++n) {
          const float* kr = kbl + (half * 8 + n) * 128 + dc * 8;
          const f32x4 k0 = *(const f32x4*)kr, k1 = *(const f32x4*)(kr + 4);
          g[n] += qq[0] * k0[0] + qq[1] * k0[1] + qq[2] * k0[2] + qq[3] * k0[3] + qq[4] * k1[0] + qq[5] * k1[1] + qq[6] * k1[2] + qq[7] * k1[3];
        }
      }
    }
    float all[16];
#pragma unroll
    for (int n = 0; n < 8; ++n) { const float go = __shfl_xor(g[n], 1); all[n] = half ? go : g[n]; all[8 + n] = half ? g[n] : go; }
    unsigned mask = 1u << own;
    const int nsel = own < 3 ? own : 3;
#pragma unroll
    for (int t = 0; t < 3; ++t) {
      if (t < nsel) {
        float best = -3.0e38f; int bi = 0;
#pragma unroll
        for (int n = 0; n < 16; ++n) { const bool ok = (n < own) && !((mask >> n) & 1u) && (all[n] > best); best = ok ? all[n] : best; bi = ok ? n : bi; }
        mask |= 1u << bi;
      }
    }
    if (half == 0) selm[ql] = mask;
    __syncthreads();
    mymask = selm[32 * w + r];
  } else {
    if (tid < 16) flags[tid] = 0;
  }
  bf16x8 tf[2];
  if (MODE == 1) {
#pragma unroll
    for (int s = 0; s < 2; ++s)
#pragma unroll
      for (int j = 0; j < 8; ++j) { const int k = 16 * s + 8 * (j >> 2) + 4 * hh + (j & 3); tf[s][j] = (k >= r) ? (short)0x3F80 : (short)0; }
  }
  f32x16 o[4];
#pragma unroll
  for (int dt = 0; dt < 4; ++dt)
#pragma unroll
    for (int i = 0; i < 16; ++i) o[dt][i] = 0.f;
  float mrun = -1e30f, lrun = 0.f, carry = 0.f;
  const int ntiles = 4 * qt + 4;
  u32x4 kreg[2], vreg[2];
#define GLOAD(kst) do { _Pragma("unroll") for (int _i = 0; _i < 2; ++_i) { const int _c = tid + 512 * _i, _key = _c >> 4, _part = _c & 15; \
      const bf16_t* _rp = proj + (tok0 + (kst) + _key) * PROJ_LD; kreg[_i] = *(const u32x4*)(_rp + kcol + _part * 8); vreg[_i] = *(const u32x4*)(_rp + vcol + _part * 8); } } while (0)
#define LSTORE(buf) do { _Pragma("unroll") for (int _i = 0; _i < 2; ++_i) { const int _c = tid + 512 * _i, _key = _c >> 4, _part = _c & 15; \
      *(u32x4*)(shm + (buf) * KBUF + _key * KP + _part * 16) = kreg[_i]; *(u32x4*)(shm + AT_V + (buf) * VBUF + _key * VP + _part * 16) = vreg[_i]; } } while (0)
#define KST(it) (MODE == 0 ? 64 * (it) : 64 * (ntiles - 1 - (it)))
  GLOAD(KST(0)); LSTORE(0); __syncthreads();
  const int i16 = lane & 15, q4 = i16 >> 2, p4 = i16 & 3, blk16 = (lane >> 4) & 1;
  bool wdone = false;
  const bool defer = (MODE == 0) && (w >= 4);
  bf16x8 pf[4]; bool pend = false; int pendbuf = 0;
#pragma unroll
  for (int ks = 0; ks < 4; ++ks) pf[ks] = (bf16x8){0, 0, 0, 0, 0, 0, 0, 0};
#define PV_STEP(PF, B) do { const char* _vb0 = shm + AT_V + (B) * VBUF + (4 * hh + q4) * VP + 32 * blk16 + 8 * p4; \
    _Pragma("unroll") for (int dt = 0; dt < 4; ++dt) _Pragma("unroll") for (int ks = 0; ks < 4; ++ks) { \
      const char* _vb = _vb0 + (ks * 16) * VP + dt * 64; \
      const s16x4 _lo = __builtin_amdgcn_ds_read_tr16_b64_v4i16((LAS s16x4*)(_vb)); \
      const s16x4 _hi = __builtin_amdgcn_ds_read_tr16_b64_v4i16((LAS s16x4*)(_vb + 8 * VP)); \
      o[dt] = mfma32(__builtin_shufflevector(_lo, _hi, 0, 1, 2, 3, 4, 5, 6, 7), PF[ks], o[dt]); } } while (0)
  int buf = 0;
  for (int it = 0; it < ntiles; ++it) {
    const int kst = KST(it), nbuf = (buf == 2) ? 0 : buf + 1;
    if (MODE == 1 && it > 0) {
      const int* fl = flags + ((it - 1) & 1) * 8;
      const int alld = fl[0] & fl[1] & fl[2] & fl[3] & fl[4] & fl[5] & fl[6] & fl[7];
      if (alld) break;
    }
    if (it + 1 < ntiles) GLOAD(KST(it + 1));
    if (defer && pend) { PV_STEP(pf, pendbuf); pend = false; }
    bool active;
    bool sel = true;
    if (MODE == 0) {
      const int j = kst >> 8;
      if (j == qt) active = (kst - q0) <= 32 * w + 31;
      else { sel = (mymask >> j) & 1u; active = __builtin_amdgcn_ballot_w64(sel) != 0ull; }
    } else {
      active = !wdone && (kst <= q0w + 31);
    }
    if (active) {
      f32x16 st[2];
#pragma unroll
      for (int sub = 0; sub < 2; ++sub) {
        f32x16 a16;
#pragma unroll
        for (int i = 0; i < 16; ++i) a16[i] = 0.f;
        const char* kb = shm + buf * KBUF + (sub * 32 + r) * KP + hh * 16;
#pragma unroll
        for (int s = 0; s < 8; ++s) a16 = mfma32(*(const bf16x8*)(kb + s * 32), qf[s], a16);
        st[sub] = a16;
      }
      if (MODE == 0) {
        __builtin_amdgcn_s_setprio(1);
        float mx = -1e30f;
        const int dmin = q0w - (kst + 63), dmax = q0w + 31 - kst;
        const int bl = rel_bucket_i(dmin < 0 ? 0 : dmin), bh = rel_bucket_i(dmax);
        if ((kst >> 8) != qt && dmin >= 16 && bh - bl <= 1) {
          int T = 1513;
          if (dmin < 1117) T = 1117; if (dmin < 825) T = 825; if (dmin < 609) T = 609; if (dmin < 450) T = 450; if (dmin < 332) T = 332;
          if (dmin < 246) T = 246; if (dmin < 182) T = 182; if (dmin < 134) T = 134; if (dmin < 99) T = 99; if (dmin < 73) T = 73;
          if (dmin < 54) T = 54; if (dmin < 40) T = 40; if (dmin < 30) T = 30; if (dmin < 22) T = 22;
          if (bh == bl) T = -(1 << 30);
          const float bhi = btab[dmax], blo = btab[dmin];
          const float hi_l = sel ? bhi : -1e30f, lo_l = sel ? blo : -1e30f;
          const int dist0 = qpos - kst - 4 * hh;
#pragma unroll
          for (int sub = 0; sub < 2; ++sub)
#pragma unroll
            for (int i = 0; i < 16; ++i) {
              const int c = sub * 32 + (i & 3) + 8 * (i >> 2);
              const float bias = (dist0 >= T + c) ? hi_l : lo_l;
              const float v = st[sub][i] * SC + bias;
              st[sub][i] = v; mx = fmaxf(mx, v);
            }
        } else {
#pragma unroll
          for (int sub = 0; sub < 2; ++sub)
#pragma unroll
            for (int i = 0; i < 16; ++i) {
              const int key = kst + sub * 32 + (i & 3) + 8 * (i >> 2) + 4 * hh;
              const int dist = qpos - key;
              const bool valid = sel && (dist >= 0);
              const float bias = btab[dist < 0 ? 0 : dist];
              const float v = valid ? st[sub][i] * SC + bias : -1e30f;
              st[sub][i] = v; mx = fmaxf(mx, v);
            }
        }
        mx = fmaxf(mx, __shfl_xor(mx, 32));
        const float mnew = fmaxf(mrun, mx);
        float ps = 0.f;
#pragma unroll
        for (int sub = 0; sub < 2; ++sub)
#pragma unroll
          for (int i = 0; i < 16; ++i) { const float pv = fexp2(st[sub][i] - mnew); st[sub][i] = pv; ps += pv; }
        if (__builtin_amdgcn_ballot_w64(mnew > mrun) != 0ull) {
          const float alpha = fexp2(mrun - mnew);
          mrun = mnew;
          lrun *= alpha;
#pragma unroll
          for (int dt = 0; dt < 4; ++dt)
#pragma unroll
            for (int i = 0; i < 16; ++i) o[dt][i] *= alpha;
        }
        lrun += ps;
        __builtin_amdgcn_s_setprio(0);
      } else {
#pragma unroll
        for (int sub = 1; sub >= 0; --sub) {
          f32x16 sp;
#pragma unroll
          for (int i = 0; i < 16; ++i) {
            const int key = kst + sub * 32 + (i & 3) + 8 * (i >> 2) + 4 * hh;
            const bool valid = key < qpos;
            const float z = st[sub][i] * SC;
            const float s = fmaxf(z, 0.f) + flog2(1.f + fexp2(-fabsf(z)));
            sp[i] = valid ? s : 0.f; st[sub][i] = z;
          }
          f32x16 c;
#pragma unroll
          for (int i = 0; i < 16; ++i) c[i] = carry;
#pragma unroll
          for (int s2 = 0; s2 < 2; ++s2) {
            u32x4 hi, lo;
#pragma unroll
            for (int jj = 0; jj < 4; ++jj) {
              const float a0 = sp[8 * s2 + 2 * jj], a1 = sp[8 * s2 + 2 * jj + 1];
              const unsigned hv = pk_bf16(a0, a1);
              hi[jj] = hv; lo[jj] = pk_bf16(a0 - bflo(hv), a1 - bfhi(hv));
            }
            c = mfma32(tf[s2], __builtin_bit_cast(bf16x8, hi), c);
            c = mfma32(tf[s2], __builtin_bit_cast(bf16x8, lo), c);
          }
          carry = __shfl(c[0], r);
#pragma unroll
          for (int i = 0; i < 16; ++i) {
            const int key = kst + sub * 32 + (i & 3) + 8 * (i >> 2) + 4 * hh;
            const bool valid = key < qpos;
            st[sub][i] = valid ? fexp2(st[sub][i] - c[i]) : 0.f;
          }
        }
        wdone = __builtin_amdgcn_ballot_w64(carry > 152.f) == ~0ull;
      }
#pragma unroll
      for (int ks = 0; ks < 4; ++ks) {
        u32x4 t;
#pragma unroll
        for (int jj = 0; jj < 4; ++jj) t[jj] = pk_bf16(st[ks >> 1][8 * (ks & 1) + 2 * jj], st[ks >> 1][8 * (ks & 1) + 2 * jj + 1]);
        pf[ks] = __builtin_bit_cast(bf16x8, t);
      }
      if (!defer) { PV_STEP(pf, buf); }
      else { pend = true; pendbuf = buf; }
    }
    if (MODE == 1) { if (lane == 0) flags[(it & 1) * 8 + w] = (wdone || (kst == 0)) ? 1 : 0; }
    if (it + 1 < ntiles) LSTORE(nbuf);
    __syncthreads();
    buf = nbuf;
  }
  if (defer && pend) { PV_STEP(pf, pendbuf); }
#undef PV_STEP
  float inv = 1.f;
  if (MODE == 0) { const float lt = lrun + __shfl_xor(lrun, 32); inv = 1.f / lt; }
  bf16_t* yp = (bf16_t*)(p->ws + OFF_Y) + (tok0 + qpos) * Y_LD + (MODE == 0 ? 0 : 2048) + h * 128 + 4 * hh;
#pragma unroll
  for (int dt = 0; dt < 4; ++dt)
#pragma unroll
    for (int g = 0; g < 4; ++g) {
      u32x2 ov; ov[0] = pk_bf16(o[dt][4 * g] * inv, o[dt][4 * g + 1] * inv); ov[1] = pk_bf16(o[dt][4 * g + 2] * inv, o[dt][4 * g + 3] * inv);
      *(u32x2*)(yp + dt * 32 + 8 * g) = ov;
    }
#undef GLOAD
#undef LSTORE
#undef KST
}

constexpr int SBW_K = 32 * KP, SBW_V = 32 * VP, SBW_LDS = SBW_K + SBW_V;
DI void sb_unit(KParams p, int b, int h, int qt, char* shm) {
  const int tid = opaque_tid(), lane = tid & 63, w = __builtin_amdgcn_readfirstlane(tid >> 6), r = lane & 31, hh = lane >> 5;
  const bf16_t* proj = (const bf16_t*)(p->ws + OFF_PROJ);
  const int qcol = 4096 + h * 128, kcol = qcol + 1024, vcol = qcol + 2048;
  const size_t tok0 = (size_t)b * SEQ;
  const int q0w = qt * 256 + 32 * w, qpos = q0w + r;
  const float SC = 0.08838834764831845f * LOG2E;
  char* kl = shm + w * SBW_LDS; char* vl = kl + SBW_K;
  __syncthreads();
  bf16x8 qf[8];
  { const bf16_t* qp = proj + (tok0 + qpos) * PROJ_LD + qcol + 8 * hh;
#pragma unroll
    for (int s = 0; s < 8; ++s) qf[s] = *(const bf16x8*)(qp + 16 * s); }
  bf16x8 tf[2];
#pragma unroll
  for (int s = 0; s < 2; ++s)
#pragma unroll
    for (int j = 0; j < 8; ++j) { const int k = 16 * s + 8 * (j >> 2) + 4 * hh + (j & 3); tf[s][j] = (k >= r) ? (short)0x3F80 : (short)0; }
  f32x16 o[4];
#pragma unroll
  for (int dt = 0; dt < 4; ++dt)
#pragma unroll
    for (int i = 0; i < 16; ++i) o[dt][i] = 0.f;
  float carry = 0.f;
  const int i16 = lane & 15, q4 = i16 >> 2, p4 = i16 & 3, blk16 = (lane >> 4) & 1;
  u32x4 kreg[4], vreg[4];
#define SB_GLOAD(kst) do { _Pragma("unroll") for (int _i = 0; _i < 4; ++_i) { const int _c = lane + 64 * _i, _key = _c >> 3, _part = _c & 7; \
      const bf16_t* _rp = proj + (tok0 + (kst) + _key) * PROJ_LD; kreg[_i] = *(const u32x4*)(_rp + kcol + _part * 16); vreg[_i] = *(const u32x4*)(_rp + vcol + _part * 16); } } while (0)
  u32x4 kreg2[4], vreg2[4];
#define SB_GLOAD2(kst) do { _Pragma("unroll") for (int _i = 0; _i < 4; ++_i) { const int _c = lane + 64 * _i, _key = _c >> 3, _part = _c & 7; \
      const bf16_t* _rp = proj + (tok0 + (kst) + _key) * PROJ_LD; kreg2[_i] = *(const u32x4*)(_rp + kcol + _part * 16 + 8); vreg2[_i] = *(const u32x4*)(_rp + vcol + _part * 16 + 8); } } while (0)
#define SB_LSTORE() do { _Pragma("unroll") for (int _i = 0; _i < 4; ++_i) { const int _c = lane + 64 * _i, _key = _c >> 3, _part = _c & 7; \
      *(u32x4*)(kl + _key * KP + _part * 32) = kreg[_i]; *(u32x4*)(kl + _key * KP + _part * 32 + 16) = kreg2[_i]; \
      *(u32x4*)(vl + _key * VP + _part * 32) = vreg[_i]; *(u32x4*)(vl + _key * VP + _part * 32 + 16) = vreg2[_i]; } } while (0)
  int kst = q0w;
  SB_GLOAD(kst); SB_GLOAD2(kst);
  for (;;) {
    SB_LSTORE();
    const int knext = kst - 32;
    if (knext >= 0) { SB_GLOAD(knext); SB_GLOAD2(knext); }
    f32x16 st;
#pragma unroll
    for (int i = 0; i < 16; ++i) st[i] = 0.f;
    { const char* kb = kl + r * KP + hh * 16;
#pragma unroll
      for (int s = 0; s < 8; ++s) st = mfma32(*(const bf16x8*)(kb + s * 32), qf[s], st); }
    f32x16 sp;
#pragma unroll
    for (int i = 0; i < 16; ++i) {
      const int key = kst + (i & 3) + 8 * (i >> 2) + 4 * hh;
      const float z = st[i] * SC;
      const float s = fmaxf(z, 0.f) + flog2(1.f + fexp2(-fabsf(z)));
      sp[i] = (key < qpos) ? s : 0.f; st[i] = z;
    }
    f32x16 c;
#pragma unroll
    for (int i = 0; i < 16; ++i) c[i] = carry;
#pragma unroll
    for (int s2 = 0; s2 < 2; ++s2) {
      u32x4 hi, lo;
#pragma unroll
      for (int jj = 0; jj < 4; ++jj) {
        const float a0 = sp[8 * s2 + 2 * jj], a1 = sp[8 * s2 + 2 * jj + 1];
        const unsigned hv = pk_bf16(a0, a1);
        hi[jj] = hv; lo[jj] = pk_bf16(a0 - bflo(hv), a1 - bfhi(hv));
      }
      c = mfma32(tf[s2], __builtin_bit_cast(bf16x8, hi), c);
      c = mfma32(tf[s2], __builtin_bit_cast(bf16x8, lo), c);
    }
    carry = __shfl(c[0], r);
    bf16x8 pf[2];
#pragma unroll
    for (int ks = 0; ks < 2; ++ks) {
      u32x4 t;
#pragma unroll
      for (int jj = 0; jj < 4; ++jj) {
        const int i0 = 8 * ks + 2 * jj, i1 = i0 + 1;
        const int key0 = kst + (i0 & 3) + 8 * (i0 >> 2) + 4 * hh, key1 = kst + (i1 & 3) + 8 * (i1 >> 2) + 4 * hh;
        const float a0 = (key0 < qpos) ? fexp2(st[i0] - c[i0]) : 0.f, a1 = (key1 < qpos) ? fexp2(st[i1] - c[i1]) : 0.f;
        t[jj] = pk_bf16(a0, a1);
      }
      pf[ks] = __builtin_bit_cast(bf16x8, t);
    }
    const char* vb0 = vl + (4 * hh + q4) * VP + 32 * blk16 + 8 * p4;
#pragma unroll
    for (int dt = 0; dt < 4; ++dt)
#pragma unroll
      for (int ks = 0; ks < 2; ++ks) {
        const char* vb = vb0 + (ks * 16) * VP + dt * 64;
        const s16x4 lo = __builtin_amdgcn_ds_read_tr16_b64_v4i16((LAS s16x4*)(vb));
        const s16x4 hi = __builtin_amdgcn_ds_read_tr16_b64_v4i16((LAS s16x4*)(vb + 8 * VP));
        o[dt] = mfma32(__builtin_shufflevector(lo, hi, 0, 1, 2, 3, 4, 5, 6, 7), pf[ks], o[dt]);
      }
    if (knext < 0 || __builtin_amdgcn_ballot_w64(carry > 152.f) == ~0ull) break;
    kst = knext;
  }
#undef SB_GLOAD
#undef SB_GLOAD2
#undef SB_LSTORE
  bf16_t* yp = (bf16_t*)(p->ws + OFF_Y) + (tok0 + qpos) * Y_LD + 2048 + h * 128 + 4 * hh;
#pragma unroll
  for (int dt = 0; dt < 4; ++dt)
#pragma unroll
    for (int g = 0; g < 4; ++g) {
      u32x2 ov; ov[0] = pk_bf16(o[dt][4 * g], o[dt][4 * g + 1]); ov[1] = pk_bf16(o[dt][4 * g + 2], o[dt][4 * g + 3]);
      *(u32x2*)(yp + dt * 32 + 8 * g) = ov;
    }
}

DI void attention_phase(KParams p, char* shm, int l) {
  {
    unsigned* qctr = (unsigned*)(p->ws + OFF_BAR) + (l ? 64 : 32);
    volatile LAS int* slot = (volatile LAS int*)(LAS char*)(shm + 8 * SBW_LDS - 16);
    for (;;) {
      __syncthreads();
      if (threadIdx.x == 0) *slot = (int)__hip_atomic_fetch_add(qctr, 1u, __ATOMIC_RELAXED, __HIP_MEMORY_SCOPE_AGENT);
      __syncthreads();
      const int u = *slot;
      if (u >= 512) break;
      attn_unit<0>(p, (u & 31) >> 3, u & 7, 15 - (u >> 5), shm);
    }
  }
  for (int k = blockIdx.x; k < 256; k += gridDim.x)
    for (int s = 0; s < 2; ++s) { const int u = s ? 511 - k : k; sb_unit(p, (u & 31) >> 3, u & 7, 15 - (u >> 5), shm); }
}

constexpr int NPHASE = 15;
DI void run_phase(KParams p, int ph, char* shm) {
  asm volatile("" : "+s"(p));
  char* ws = p->ws;
  const int l = ph == 0 ? 0 : (ph - 1) / 7, sp0 = ph == 0 ? -1 : (ph - 1) % 7, sp = sp0 >= 1 ? sp0 + 1 : sp0;
  if (ph == 0 || (sp == 7 && l == 0)) { convert_layer(p, ph == 0 ? 0 : 1, shm); if (ph == 0) x_prep(p); return; }
  if (sp == 7) { final_norm(p); return; }
  if (sp == 2) attention_phase(p, shm, l);
  if (sp == 3) { branch_phase(p, shm); return; }
  const bf16_t* A; const bf16_t* Bt; int lda, ldb, K, nN, kind, nsub = 1, acs = 0, oc0 = 0, ocs = 256; const float* hin = nullptr;
  size_t asub = 0, bsub = 0;
  if (sp == 0) { A = (const bf16_t*)(ws + OFF_XB); lda = XB_LD; Bt = (const bf16_t*)(ws + OFF_WIN); ldb = DM; K = DM; nN = 52; kind = EPI_IN; }
  else if (sp == 2) { A = (const bf16_t*)(ws + OFF_P); lda = P_LD; Bt = (const bf16_t*)(ws + OFF_WPOOL); ldb = 256; K = 256; nN = 4; kind = EPI_POOL; acs = 256; oc0 = 1024; }
  else if (sp == 3) { A = (const bf16_t*)(ws + OFF_Y); lda = Y_LD; Bt = (const bf16_t*)(ws + OFF_WBR); ldb = 1024; K = 1024; nN = 8; kind = EPI_BR; nsub = 3; asub = 1024; bsub = SZ_WBR1 / 2; }
  else if (sp == 4) { A = (const bf16_t*)(ws + OFF_PROJ); lda = M_LD; Bt = (const bf16_t*)(ws + OFF_WOUT); ldb = DM; K = DM; nN = 8; kind = EPI_RES; }
  else if (sp == 5) { A = (const bf16_t*)(ws + OFF_XB); lda = XB_LD; Bt = (const bf16_t*)(ws + OFF_WGU); ldb = DM; K = DM; nN = 44; kind = EPI_FFN1; ocs = 128; }
  else { A = (const bf16_t*)(ws + OFF_PROJ); lda = ACT_LD; Bt = (const bf16_t*)(ws + OFF_WDOWN); ldb = DFF; K = DFF; nN = 8; kind = EPI_RES; }
  gemm_phase(p, A, lda, Bt, ldb, K, nN, kind, nsub, asub, bsub, acs, oc0, ocs, hin, shm);
}

constexpr int LDS_BYTES = 8 * SBW_LDS + 16 > GEMM_LDS + 2048 + 16 ? 8 * SBW_LDS + 16 : GEMM_LDS + 2048 + 16;

__global__ void __launch_bounds__(512, 2) hybrid_megakernel(Params p_arg) {
  extern __shared__ __attribute__((aligned(16))) char shm[];
  KParams kp = (KParams)__builtin_amdgcn_kernarg_segment_ptr();
  const int phase_lo = kp->phase_lo, phase_hi = kp->phase_hi;
  volatile LAS unsigned* xst = (volatile LAS unsigned*)(LAS char*)(shm + LDS_BYTES - 16);
  const bool multi = phase_hi - phase_lo > 1;
  XcdBarrier xb{};
  if (multi) {
    if (threadIdx.x == 0) { xst[0] = 0u; xst[1] = 0u; }
    __syncthreads();
    xb = xcd_barrier_post((unsigned*)(kp->ws + OFF_BAR), xst);
  }
  for (int ph = phase_lo; ph < phase_hi; ++ph) {
    if (ph > phase_lo) { if (ph == 1) cg::this_grid().sync(); else xcd_barrier(xb, (unsigned*)(kp->ws + OFF_BAR)); }
    run_phase(kp, ph, shm);
  }
}

#ifndef SINGLE_LAUNCH
#define SINGLE_LAUNCH 1
#endif

extern "C" void kernel_launch(void* const* d_in, const int* in_sizes, int n_in, void* d_out, int out_size, void* d_ws, size_t ws_size, hipStream_t stream) {
  static int grid_blocks = 0;
  if (!grid_blocks) {
    hipFuncSetAttribute((const void*)hybrid_megakernel, hipFuncAttributeMaxDynamicSharedMemorySize, LDS_BYTES);
    int dev = 0, cus = 0, per_cu = 0;
    hipGetDevice(&dev);
    hipDeviceGetAttribute(&cus, hipDeviceAttributeMultiprocessorCount, dev);
    hipOccupancyMaxActiveBlocksPerMultiprocessor(&per_cu, hybrid_megakernel, 512, LDS_BYTES);
    if (per_cu < 1) per_cu = 1;
    grid_blocks = cus * per_cu;
    if (ws_size < WS_NEED) fprintf(stderr, "workspace too small: %zu < %zu\n", ws_size, (size_t)WS_NEED);
  }
  Params p{};
  p.x = (const float*)d_in[0]; p.norm_mix = (const float*)d_in[1]; p.norm_ffn = (const float*)d_in[2]; p.w_in = (const float*)d_in[3];
  p.w_pool = (const float*)d_in[4]; p.pool_scale = (const float*)d_in[5]; p.w_br_a = (const float*)d_in[6]; p.w_br_b = (const float*)d_in[7];
  p.w_br_c = (const float*)d_in[8]; p.w_out = (const float*)d_in[9]; p.w_gate = (const float*)d_in[10]; p.w_up = (const float*)d_in[11];
  p.w_down = (const float*)d_in[12]; p.rel_bias = (const float*)d_in[13]; p.norm_final = (const float*)d_in[14];
  p.out = (float*)d_out; p.ws = (char*)d_ws;
#if SINGLE_LAUNCH
  hipMemsetAsync((char*)d_ws + OFF_BAR, 0, 16384, stream);
  p.phase_lo = 0; p.phase_hi = NPHASE;
  void* args[] = {&p};
  hipError_t e = hipLaunchCooperativeKernel((const void*)hybrid_megakernel, dim3(grid_blocks), dim3(512), args, LDS_BYTES, stream);
  if (e != hipSuccess) fprintf(stderr, "cooperative launch failed: %s (grid %d)\n", hipGetErrorString(e), grid_blocks);
#else
  for (int ph = 0; ph < NPHASE; ++ph) {
    p.phase_lo = ph; p.phase_hi = ph + 1;
    hipLaunchKernelGGL(hybrid_megakernel, dim3(grid_blocks), dim3(512), LDS_BYTES, stream, p);
  }
#endif
}
```

```cpp
#include <hip/hip_runtime.h>
#include <hip/hip_cooperative_groups.h>
#include <cstdio>
namespace cg = cooperative_groups;
#ifndef REP_N
#define REP_N 1
#define REP_PH 0
#endif

#define LAS __attribute__((address_space(3)))
#define DI __device__ __forceinline__
typedef unsigned short bf16_t;
typedef short bf16x8 __attribute__((ext_vector_type(8)));
typedef short s16x4 __attribute__((ext_vector_type(4)));
typedef float f32x4 __attribute__((ext_vector_type(4)));
typedef float f32x16 __attribute__((ext_vector_type(16)));
typedef unsigned u32x4 __attribute__((ext_vector_type(4)));
typedef unsigned u32x2 __attribute__((ext_vector_type(2)));

constexpr int DM = 2048, NBATCH = 4, SEQ = 4096, MTOK = NBATCH * SEQ, INW = 13312, DFF = 5632;
constexpr int PAD = 128;
constexpr int PROJ_W = 7168, PROJ_LD = PROJ_W + PAD, GATE_LD = 6144 + PAD, Y_LD = 3072 + PAD, XB_LD = DM + PAD, M_LD = DM + PAD, ACT_LD = DFF + PAD, P_LD = 1024 + PAD;
constexpr float LOG2E = 1.4426950408889634f;

constexpr size_t SZ_WIN = (size_t)INW * DM * 2;
constexpr size_t SZ_WPOOL = (size_t)4 * 256 * 256 * 2;
constexpr size_t SZ_WBR1 = (size_t)DM * 1024 * 2;
constexpr size_t SZ_WOUT = (size_t)DM * DM * 2;
constexpr size_t SZ_WGU = (size_t)2 * DFF * DM * 2;
constexpr size_t SZ_WDOWN = (size_t)DM * DFF * 2;
constexpr size_t OFF_WIN = 0;
constexpr size_t OFF_WPOOL = OFF_WIN + SZ_WIN;
constexpr size_t OFF_WBR = OFF_WPOOL + SZ_WPOOL;
constexpr size_t OFF_WOUT = OFF_WBR + 3 * SZ_WBR1;
constexpr size_t OFF_WGU = OFF_WOUT + SZ_WOUT;
constexpr size_t OFF_WDOWN = OFF_WGU + SZ_WGU;
constexpr size_t OFF_PROJ = OFF_WDOWN + SZ_WDOWN;
constexpr size_t OFF_GATES = OFF_PROJ + (size_t)MTOK * PROJ_LD * 2;
constexpr size_t OFF_XB = OFF_GATES + (size_t)MTOK * GATE_LD * 2;
constexpr size_t OFF_Y = OFF_XB + (size_t)MTOK * XB_LD * 2;
constexpr size_t OFF_P = OFF_Y + (size_t)MTOK * Y_LD * 2;
constexpr size_t OFF_SSQ = OFF_P + (size_t)MTOK * P_LD * 2;
constexpr size_t OFF_KBAR = OFF_SSQ + (size_t)MTOK * 32 * 4;
constexpr size_t OFF_BAR = OFF_KBAR + (size_t)4 * 16 * 2 * 1024 * 4;
constexpr size_t WS_NEED = OFF_BAR + 16384;

struct Params {
  const float *x, *norm_mix, *norm_ffn, *w_in, *w_pool, *pool_scale, *w_br_a, *w_br_b, *w_br_c, *w_out, *w_gate, *w_up, *w_down, *rel_bias, *norm_final;
  float* out;
  char* ws;
  int phase_lo, phase_hi;
};
typedef const __attribute__((address_space(4))) Params* KParams;

DI const char* uni_ptr(const char* q) { const unsigned long long v = (unsigned long long)q; const unsigned lo = __builtin_amdgcn_readfirstlane((unsigned)v), hi = __builtin_amdgcn_readfirstlane((unsigned)(v >> 32)); return (const char*)(((unsigned long long)hi << 32) | lo); }
DI int opaque_tid() { int t = threadIdx.x; asm volatile("" : "+v"(t)); return t; }
DI unsigned pk_bf16(float lo, float hi) { unsigned r; asm("v_cvt_pk_bf16_f32 %0, %1, %2" : "=v"(r) : "v"(lo), "v"(hi)); return r; }
DI float bflo(unsigned v) { return __uint_as_float(v << 16); }
DI float bfhi(unsigned v) { return __uint_as_float(v & 0xffff0000u); }
DI float fexp2(float x) { return __builtin_amdgcn_exp2f(x); }
DI float flog2(float x) { return __builtin_amdgcn_logf(x); }
DI f32x16 mfma32(bf16x8 a, bf16x8 b, f32x16 c) { return __builtin_amdgcn_mfma_f32_32x32x16_bf16(a, b, c, 0, 0, 0); }


#define XB_TMO      128
#define XB_XCNT(j)  (256  + 64 * (j))
#define XB_XSUB(j)  (1280 + 64 * (j))
#define XB_XGEN(j)  (2304 + 64 * (j))
#define XB_TOP      3328
#define XB_TOPGEN   3392
#define XCD_BAR_WORDS 3456
#define XB_SPIN_CAP (1u << 18)
DI unsigned xb_ld(unsigned* q) { return __hip_atomic_load(q, __ATOMIC_RELAXED, __HIP_MEMORY_SCOPE_AGENT); }
DI unsigned xb_add(unsigned* q, unsigned v) { return __hip_atomic_fetch_add(q, v, __ATOMIC_RELAXED, __HIP_MEMORY_SCOPE_AGENT); }
DI unsigned xb_xcc_id() { return (unsigned)__builtin_amdgcn_s_getreg((3 << 11) | 20) & 0xFu; }
#define XB_SPIN(cond, bar) do { unsigned _sp = 0; while (cond) { __builtin_amdgcn_s_sleep(1); \
    if ((++_sp & 255u) == 0u) { if (xb_ld(&(bar)[XB_TMO])) break; if (_sp > XB_SPIN_CAP) { atomicAdd(&(bar)[XB_TMO], 1u); break; } } } } while (0)
struct XcdBarrier { unsigned* bar; unsigned x; volatile LAS unsigned* st; };
DI XcdBarrier xcd_barrier_post(unsigned* bar, volatile LAS unsigned* st) {
  XcdBarrier b; b.bar = bar; b.x = xb_xcc_id(); b.st = st;
  if (threadIdx.x == 0) (void)xb_add(&bar[XB_XCNT(b.x)], 1u);
  return b;
}
DI void xcd_barrier_complete(unsigned* bar, unsigned x, unsigned& nloc, unsigned& nx) {
  const unsigned G = gridDim.x * gridDim.y * gridDim.z;
  unsigned sum, cnt, mine, sp = 0u;
  for (;;) {
    sum = 0u; cnt = 0u; mine = 0u;
#pragma unroll
    for (unsigned j = 0; j < 16; ++j) { const unsigned c = xb_ld(&bar[XB_XCNT(j)]); sum += c; cnt += (c > 0u) ? 1u : 0u; mine = (j == x) ? c : mine; }
    if (sum == G) break;
    __builtin_amdgcn_s_sleep(1);
    if ((++sp & 255u) == 0u) { if (xb_ld(&bar[XB_TMO])) break; if (sp > XB_SPIN_CAP) { atomicAdd(&bar[XB_TMO], 1u); break; } }
  }
  nloc = mine > 0u ? mine : 1u; nx = cnt > 0u ? cnt : 1u;
}
DI void xcd_barrier(const XcdBarrier& b, unsigned* bar_in) {
  asm volatile("s_waitcnt vmcnt(0)" ::: "memory");
  __syncthreads();
  if (threadIdx.x == 0) {
    unsigned* bar = bar_in;
    __builtin_amdgcn_s_waitcnt(0);
    unsigned nloc = b.st[0], nx = b.st[1];
    if (nloc == 0u) { xcd_barrier_complete(bar, b.x, nloc, nx); b.st[0] = nloc; b.st[1] = nx; }
    const unsigned old = xb_add(&bar[XB_XSUB(b.x)], 1u);
    const unsigned gen = old / nloc;
    if (old + 1u == (gen + 1u) * nloc) {
      __builtin_amdgcn_fence(__ATOMIC_RELEASE, "agent");
      asm volatile("s_waitcnt vmcnt(0)" ::: "memory");
      const unsigned og = xb_add(&bar[XB_TOP], 1u);
      const unsigned tg = og / nx;
      if (og + 1u == (tg + 1u) * nx) xb_add(&bar[XB_TOPGEN], 1u);
      else XB_SPIN(xb_ld(&bar[XB_TOPGEN]) == tg, bar);
      __builtin_amdgcn_fence(__ATOMIC_ACQUIRE, "agent");
      xb_add(&bar[XB_XGEN(b.x)], 1u);
      asm volatile("s_waitcnt vmcnt(0)" ::: "memory");
    } else {
      XB_SPIN(xb_ld(&bar[XB_XGEN(b.x)]) == gen, bar);
      __builtin_amdgcn_fence(__ATOMIC_ACQUIRE, "agent");
      asm volatile("s_waitcnt vmcnt(0)" ::: "memory");
    }
  }
  __syncthreads();
}

struct CvtTile { const float* src; bf16_t* dst; const float* rs; const float* cs; int K, N, blk, bs, off, kt, nt; };
constexpr int CVT_T0 = 32 * 52, CVT_T1 = CVT_T0 + 16, CVT_T2 = CVT_T1 + 3 * 128, CVT_T3 = CVT_T2 + 256, CVT_T4 = CVT_T3 + 2 * 704, CVT_TOTAL = CVT_T4 + 704;
DI CvtTile cvt_tile(KParams p, int l, int t) {
  char* ws = p->ws; CvtTile c; c.rs = nullptr; c.cs = nullptr; c.bs = 0; c.off = 0;
  int tt;
  if (t < CVT_T0) { tt = t; c.src = p->w_in + (size_t)l * DM * INW; c.dst = (bf16_t*)(ws + OFF_WIN); c.K = DM; c.N = INW; c.blk = INW; c.rs = p->norm_mix + l * DM; }
  else if (t < CVT_T1) { const int g = (t - CVT_T0) >> 2; tt = (t - CVT_T0) & 3; c.src = p->w_pool + ((size_t)l * 4 + g) * 65536; c.dst = (bf16_t*)(ws + OFF_WPOOL) + g * 65536; c.K = 256; c.N = 256; c.blk = 256; c.cs = p->pool_scale + l * 1024 + g * 256; }
  else if (t < CVT_T2) { const int b = (t - CVT_T1) >> 7; tt = (t - CVT_T1) & 127; const float* wa = p->w_br_a; const float* wb = p->w_br_b; const float* wc3 = p->w_br_c; asm volatile("" : "+s"(wa), "+s"(wb), "+s"(wc3)); c.src = (b == 0 ? wa : b == 1 ? wb : wc3) + (size_t)l * 1024 * DM; c.dst = (bf16_t*)(ws + OFF_WBR + b * SZ_WBR1); c.K = 1024; c.N = DM; c.blk = DM; }
  else if (t < CVT_T3) { tt = t - CVT_T2; c.src = p->w_out + (size_t)l * DM * DM; c.dst = (bf16_t*)(ws + OFF_WOUT); c.K = DM; c.N = DM; c.blk = DM; }
  else if (t < CVT_T4) { const int u = (t - CVT_T3) >= 704; tt = (t - CVT_T3) - u * 704; const float* wg = p->w_gate; const float* wu = p->w_up; asm volatile("" : "+s"(wg), "+s"(wu)); c.src = (u ? wu : wg) + (size_t)l * DM * DFF; c.dst = (bf16_t*)(ws + OFF_WGU); c.K = DM; c.N = DFF; c.blk = 128; c.bs = 256; c.off = u * 128; c.rs = p->norm_ffn + l * DM; }
  else { tt = t - CVT_T4; c.src = p->w_down + (size_t)l * DFF * DM; c.dst = (bf16_t*)(ws + OFF_WDOWN); c.K = DFF; c.N = DM; c.blk = DM; }
  const int ntn = c.N >> 8; c.kt = tt / ntn; c.nt = tt - c.kt * ntn;
  return c;
}

DI void convert_layer(KParams p, int l, char* shm) {
  float* tile = (float*)shm;
  const int tid = opaque_tid(), lane = tid & 63, w = tid >> 6;
  f32x4 v[8];
#define CVT_LOAD(tt) do { const CvtTile _c = cvt_tile(p, l, (tt)); \
    _Pragma("unroll") for (int i = 0; i < 8; ++i) { const int idx = tid + 512 * i, k = idx >> 6, n4 = idx & 63; v[i] = *(const f32x4*)(_c.src + (size_t)(_c.kt * 64 + k) * _c.N + _c.nt * 256 + 4 * n4); } } while (0)
  if ((int)blockIdx.x < CVT_TOTAL) CVT_LOAD(blockIdx.x);
  for (int t = blockIdx.x; t < CVT_TOTAL; t += gridDim.x) {
    const CvtTile c = cvt_tile(p, l, t);
    const int k0 = c.kt * 64, n0 = c.nt * 256;
    __syncthreads();
#pragma unroll
    for (int i = 0; i < 8; ++i) { const int idx = tid + 512 * i, k = idx >> 6, n4 = idx & 63; *(f32x4*)(tile + k * 256 + 4 * (n4 ^ ((k >> 3) & 7))) = v[i]; }
    __syncthreads();
    if (t + (int)gridDim.x < CVT_TOTAL) CVT_LOAD(t + gridDim.x);
    const int kc = lane >> 3;
    f32x4 g0 = {1.f, 1.f, 1.f, 1.f}, g1 = g0;
    if (c.rs) { g0 = *(const f32x4*)(c.rs + k0 + kc * 8); g1 = *(const f32x4*)(c.rs + k0 + kc * 8 + 4); }
#pragma unroll
    for (int pass = 0; pass < 4; ++pass) {
      const int n = 32 * w + 8 * pass + (lane & 7);
      float f[8];
#pragma unroll
      for (int j = 0; j < 8; ++j) f[j] = tile[(kc * 8 + j) * 256 + 4 * ((n >> 2) ^ kc) + (n & 3)];
      const int ng = n0 + n;
      const float cc = c.cs ? c.cs[ng] : 1.f;
      u32x4 o;
      o[0] = pk_bf16(f[0] * g0[0] * cc, f[1] * g0[1] * cc); o[1] = pk_bf16(f[2] * g0[2] * cc, f[3] * g0[3] * cc);
      o[2] = pk_bf16(f[4] * g1[0] * cc, f[5] * g1[1] * cc); o[3] = pk_bf16(f[6] * g1[2] * cc, f[7] * g1[3] * cc);
      const int q = ng / c.blk, dr0 = q * c.bs + c.off + (ng - q * c.blk);
      const int c32 = dr0 & 31, drow = (dr0 & ~31) + 16 * ((c32 >> 2) & 1) + 4 * (c32 >> 3) + (c32 & 3);
      *(u32x4*)(c.dst + (size_t)drow * c.K + k0 + kc * 8) = o;
    }
  }
#undef CVT_LOAD
}

DI void x_prep(KParams p) {
  const int tid = opaque_tid(), lane = tid & 63, w = tid >> 6;
  bf16_t* xb = (bf16_t*)(p->ws + OFF_XB); float* ssq = (float*)(p->ws + OFF_SSQ);
  const float* x = p->x;
  for (int row = blockIdx.x * 8 + w; row < MTOK; row += gridDim.x * 16) {
    const int row2 = row + gridDim.x * 8;
    const bool has2 = row2 < MTOK;
    f32x4 va[8], vb[8];
#pragma unroll
    for (int i = 0; i < 8; ++i) { const int c = (i * 64 + lane) * 4; va[i] = *(const f32x4*)(x + (size_t)row * DM + c); vb[i] = has2 ? *(const f32x4*)(x + (size_t)row2 * DM + c) : (f32x4){0.f, 0.f, 0.f, 0.f}; }
    float s0 = 0.f, s1 = 0.f;
#pragma unroll
    for (int i = 0; i < 8; ++i) {
      const int c = (i * 64 + lane) * 4;
      s0 += va[i][0] * va[i][0] + va[i][1] * va[i][1] + va[i][2] * va[i][2] + va[i][3] * va[i][3];
      s1 += vb[i][0] * vb[i][0] + vb[i][1] * vb[i][1] + vb[i][2] * vb[i][2] + vb[i][3] * vb[i][3];
      u32x2 o; o[0] = pk_bf16(va[i][0], va[i][1]); o[1] = pk_bf16(va[i][2], va[i][3]);
      *(u32x2*)(xb + (size_t)row * XB_LD + c) = o;
      if (has2) { u32x2 o2; o2[0] = pk_bf16(vb[i][0], vb[i][1]); o2[1] = pk_bf16(vb[i][2], vb[i][3]); *(u32x2*)(xb + (size_t)row2 * XB_LD + c) = o2; }
    }
    s0 += __shfl_xor(s0, 32); s1 += __shfl_xor(s1, 32);
    if (lane < 32) { ssq[(size_t)row * 32 + lane] = s0; if (has2) ssq[(size_t)row2 * 32 + lane] = s1; }
  }
}

DI void final_norm(KParams p) {
  const int tid = opaque_tid(), lane = tid & 63, w = tid >> 6;
  const float* ssq = (const float*)(p->ws + OFF_SSQ);
  const bf16_t* xb = (const bf16_t*)(p->ws + OFF_XB);
  float* out = p->out;
  f32x4 g[4][2];
#pragma unroll
  for (int i = 0; i < 4; ++i) { g[i][0] = *(const f32x4*)(p->norm_final + (i * 64 + lane) * 8); g[i][1] = *(const f32x4*)(p->norm_final + (i * 64 + lane) * 8 + 4); }
  for (int row = blockIdx.x * 8 + w; row < MTOK; row += gridDim.x * 16) {
    const int row2 = row + gridDim.x * 8;
    const bool has2 = row2 < MTOK;
    float s0 = (lane < 32) ? ssq[(size_t)row * 32 + lane] : 0.f, s1 = (lane < 32 && has2) ? ssq[(size_t)row2 * 32 + lane] : 0.f;
    u32x4 va[4], vb[4];
#pragma unroll
    for (int i = 0; i < 4; ++i) { const int c = (i * 64 + lane) * 8; va[i] = *(const u32x4*)(xb + (size_t)row * XB_LD + c); vb[i] = has2 ? *(const u32x4*)(xb + (size_t)row2 * XB_LD + c) : (u32x4){0u, 0u, 0u, 0u}; }
#pragma unroll
    for (int o = 32; o >= 1; o >>= 1) { s0 += __shfl_xor(s0, o); s1 += __shfl_xor(s1, o); }
    const float r0 = rsqrtf(s0 * (1.f / DM) + 1e-6f), r1 = rsqrtf(s1 * (1.f / DM) + 1e-6f);
#pragma unroll
    for (int i = 0; i < 4; ++i) {
      const int c = (i * 64 + lane) * 8;
      f32x4 a, b;
      a[0] = bflo(va[i][0]) * r0 * g[i][0][0]; a[1] = bfhi(va[i][0]) * r0 * g[i][0][1]; a[2] = bflo(va[i][1]) * r0 * g[i][0][2]; a[3] = bfhi(va[i][1]) * r0 * g[i][0][3];
      b[0] = bflo(va[i][2]) * r0 * g[i][1][0]; b[1] = bfhi(va[i][2]) * r0 * g[i][1][1]; b[2] = bflo(va[i][3]) * r0 * g[i][1][2]; b[3] = bfhi(va[i][3]) * r0 * g[i][1][3];
      *(f32x4*)(out + (size_t)row * DM + c) = a; *(f32x4*)(out + (size_t)row * DM + c + 4) = b;
      if (has2) {
        a[0] = bflo(vb[i][0]) * r1 * g[i][0][0]; a[1] = bfhi(vb[i][0]) * r1 * g[i][0][1]; a[2] = bflo(vb[i][1]) * r1 * g[i][0][2]; a[3] = bfhi(vb[i][1]) * r1 * g[i][0][3];
        b[0] = bflo(vb[i][2]) * r1 * g[i][1][0]; b[1] = bfhi(vb[i][2]) * r1 * g[i][1][1]; b[2] = bflo(vb[i][3]) * r1 * g[i][1][2]; b[3] = bfhi(vb[i][3]) * r1 * g[i][1][3];
        *(f32x4*)(out + (size_t)row2 * DM + c) = a; *(f32x4*)(out + (size_t)row2 * DM + c + 4) = b;
      }
    }
  }
}

DI void pool_tile(KParams p, int brow, int g) {
  const bf16_t* proj = (const bf16_t*)(p->ws + OFF_PROJ);
  bf16_t* P = (bf16_t*)(p->ws + OFF_P);
  const int tid = opaque_tid();
  const int win = 2 << g;
  for (int it = 0; it < 16; it += 2) {
    const int idx0 = it * 512 + tid, idx1 = idx0 + 512, c = g * 256 + (tid & 31) * 8;
    const int tok0 = brow + (idx0 >> 5), tok1 = brow + (idx1 >> 5);
    const int cnt0 = min(win, (tok0 & (SEQ - 1)) + 1), cnt1 = min(win, (tok1 & (SEQ - 1)) + 1);
    const bf16_t* up0 = proj + (size_t)tok0 * PROJ_LD + 3072 + c;
    const bf16_t* up1 = proj + (size_t)tok1 * PROJ_LD + 3072 + c;
    u32x4 ua[16], ub[16];
#pragma unroll
    for (int j = 0; j < 16; ++j) {
      ua[j] = (j < cnt0) ? *(const u32x4*)(up0 - (size_t)j * PROJ_LD) : (u32x4){0u, 0u, 0u, 0u};
      ub[j] = (j < cnt1) ? *(const u32x4*)(up1 - (size_t)j * PROJ_LD) : (u32x4){0u, 0u, 0u, 0u};
    }
    float a0[8] = {0.f, 0.f, 0.f, 0.f, 0.f, 0.f, 0.f, 0.f}, a1[8] = {0.f, 0.f, 0.f, 0.f, 0.f, 0.f, 0.f, 0.f};
#pragma unroll
    for (int j = 0; j < 16; ++j) {
#pragma unroll
      for (int e = 0; e < 4; ++e) { a0[2 * e] += bflo(ua[j][e]); a0[2 * e + 1] += bfhi(ua[j][e]); a1[2 * e] += bflo(ub[j][e]); a1[2 * e + 1] += bfhi(ub[j][e]); }
    }
    const float i0 = 1.f / (float)cnt0, i1 = 1.f / (float)cnt1;
    u32x4 o0, o1;
#pragma unroll
    for (int e = 0; e < 4; ++e) {
      o0[e] = pk_bf16(a0[2 * e] * i0 - bflo(ua[0][e]), a0[2 * e + 1] * i0 - bfhi(ua[0][e]));
      o1[e] = pk_bf16(a1[2 * e] * i1 - bflo(ub[0][e]), a1[2 * e + 1] * i1 - bfhi(ub[0][e]));
    }
    *(u32x4*)(P + (size_t)tok0 * P_LD + c) = o0;
    *(u32x4*)(P + (size_t)tok1 * P_LD + c) = o1;
  }
}

constexpr int BK = 64, HALF = 128, HT = HALF * BK;
constexpr int GEMM_LDS = 8 * HT * 2;
constexpr int RS_OFF = GEMM_LDS;
enum { EPI_IN = 0, EPI_POOL = 1, EPI_BR = 2, EPI_RES = 3, EPI_FFN1 = 4 };

DI int lds_byte(int r, int c) { const int st = (r >> 4) * 2 + (c >> 5), rr = r & 15, cc = c & 31, ob = rr * 64 + cc * 2; return st * 1024 + (ob ^ (((ob >> 9) & 1) << 5)); }
DI void stage_rc(int b, int& R, int& C) { const int st = b / 1024, sb = b % 1024, swz = sb ^ (((sb >> 9) & 1) << 5); R = (st >> 1) * 16 + swz / 64; C = (st & 1) * 32 + (swz % 64) / 2; }

DI bool tile_order(int L, int nM, int nN, int& pm, int& pn) {
  const int nwg = nM * nN; if (L >= nwg) return false;
  int wgid = L; { const int q = nwg / 8, r = nwg % 8, xcd = wgid % 8, off = wgid / 8; wgid = (xcd < r ? xcd * (q + 1) : r * (q + 1) + (xcd - r) * q) + off; }
  const int nig = 8 * nN, gid = wgid / nig, fm = gid * 8, gsz = (nM - fm) < 8 ? (nM - fm) : 8;
  pm = fm + ((wgid % nig) % gsz); pn = (wgid % nig) / gsz; return true;
}

DI void gemm_phase(KParams p, const bf16_t* __restrict__ A, int lda, const bf16_t* __restrict__ Bt, int ldb, int K, int nN, int kind,
                   int nsub, size_t asub, size_t bsub, int acs, int oc0, int ocs, const float* hin, char* shmc) {
  LAS unsigned char* lds = (LAS unsigned char*)shmc;
  const int tid = opaque_tid();
  const int wid = __builtin_amdgcn_readfirstlane(tid >> 6), lane = tid & 63, wr = wid >> 2, wc = wid & 3, fr = lane & 15, fq = lane >> 4;
  unsigned voffA[2], voffB[2];
#pragma unroll
  for (int i = 0; i < 2; ++i) { int R, C; stage_rc(tid * 16 + i * 8192, R, C); voffA[i] = (unsigned)(R * lda + C) * 2u; voffB[i] = (unsigned)(R * ldb + C) * 2u; }
  const unsigned ldsw = (unsigned)wid * 1024u;
  const int aoff = lds_byte(wr * 64 + fr, fq * 8), boff = lds_byte(wc * 32 + fr, fq * 8);
  const size_t hA = (size_t)HALF * lda * 2, hB = (size_t)HALF * ldb * 2;
#define SA(b, h) (((b) * 2 + (h)) * (HT * 2))
#define SB(b, h) ((4 + (b) * 2 + (h)) * (HT * 2))
#define STAGE(bufoff, gbase, voff) do { const char* _gb = uni_ptr(gbase); _Pragma("unroll") for (int _i = 0; _i < 2; ++_i) { unsigned _vo = (voff)[_i]; asm volatile("" : "+v"(_vo)); \
    __builtin_amdgcn_global_load_lds((const unsigned*)(_gb + _vo), (LAS unsigned*)(lds + (bufoff) + ldsw + _i * 8192), 16, 0, 0); } } while (0)
#define STA(P, hf, kt) STAGE(P, cA + (hf) * hA + (size_t)(kt) * (BK * 2), voffA)
#define STB(P, hf, kt) STAGE(P, cB + (hf) * hB + (size_t)(kt) * (BK * 2), voffB)
#define ISSUE_PROLOGUE() do { STB(SB(0, 0), 0, 0); STA(SA(0, 0), 0, 0); STB(SB(0, 1), 1, 0); STA(SA(0, 1), 1, 0); \
    STB(SB(1, 0), 0, 1); STA(SA(1, 0), 0, 1); STB(SB(1, 1), 1, 1); } while (0)
#define LDA(dst, b, h) do { _Pragma("unroll") for (int m = 0; m < 4; ++m) _Pragma("unroll") for (int k = 0; k < 2; ++k) dst[m][k] = *(const LAS bf16x8*)(lds + SA(b, h) + aoff + m * 2048 + k * 1024); } while (0)
#define LDB(dst, b, h) do { _Pragma("unroll") for (int n = 0; n < 2; ++n) _Pragma("unroll") for (int k = 0; k < 2; ++k) dst[n][k] = *(const LAS bf16x8*)(lds + SB(b, h) + boff + n * 2048 + k * 1024); } while (0)
#define MMA(ai, bj, Af, Bf) do { __builtin_amdgcn_s_setprio(1); \
    _Pragma("unroll") for (int m = 0; m < 4; ++m) _Pragma("unroll") for (int n = 0; n < 2; ++n) _Pragma("unroll") for (int k = 0; k < 2; ++k) \
      acc[ai][bj][m][n] = __builtin_amdgcn_mfma_f32_16x16x32_bf16(Bf[n][k], Af[m][k], acc[ai][bj][m][n], 0, 0, 0); \
    __builtin_amdgcn_s_setprio(0); } while (0)
#define WAIT_V(n) asm volatile("s_waitcnt vmcnt(" #n ")" ::: "memory")
#define WAIT_L(n) asm volatile("s_waitcnt lgkmcnt(" #n ")" ::: "memory")
#define BAR __builtin_amdgcn_s_barrier()
#define SCHED __builtin_amdgcn_sched_barrier(0)

  int pm, pn, sub = 0, rnd = 0, rs_brow = -1;
  if (!tile_order(blockIdx.x, 64, nN, pm, pn)) return;
  const char* cA = (const char*)(A + pn * acs) + (size_t)pm * 256 * lda * 2;
  const char* cB = (const char*)Bt + (size_t)pn * 256 * ldb * 2;
  if (kind == EPI_POOL) {
    int qm, qn;
    for (int r2 = 0; tile_order(r2 * gridDim.x + blockIdx.x, 64, nN, qm, qn); ++r2) pool_tile(p, qm * 256, qn);
    asm volatile("s_waitcnt vmcnt(0)" ::: "memory");
  }
  __syncthreads();
  ISSUE_PROLOGUE();
  const int nt = K / BK;
  bool have = true;
  while (have) {
    const int brow = pm * 256, ocol = oc0 + pn * ocs, aux = sub;
    float* rsl = (float*)(shmc + RS_OFF);
    if ((kind == EPI_IN || kind == EPI_FFN1) && brow != rs_brow) {
      rs_brow = brow;
      __syncthreads();
      if (tid < 256) {
        const float* sp = (const float*)(p->ws + OFF_SSQ) + (size_t)(brow + tid) * 32;
        float s = 0.f;
#pragma unroll
        for (int i = 0; i < 8; ++i) { const f32x4 v = *(const f32x4*)(sp + 4 * i); s += (v[0] + v[1]) + (v[2] + v[3]); }
        rsl[tid] = rsqrtf(s * (1.f / DM) + 1e-6f);
      }
    }
    f32x4 acc[2][2][4][2];
#pragma unroll
    for (int a = 0; a < 2; ++a)
#pragma unroll
      for (int b = 0; b < 2; ++b)
#pragma unroll
        for (int m = 0; m < 4; ++m)
#pragma unroll
          for (int n = 0; n < 2; ++n) acc[a][b][m][n] = (f32x4){0.f, 0.f, 0.f, 0.f};
    bf16x8 At[4][2], B0[2][2], B1[2][2];
    if (wr == 1) BAR;
    WAIT_V(10); BAR;
    WAIT_V(6); BAR;
    for (int t = 0; t < nt - 2; t += 2) {
      LDB(B0, 0, 0); SCHED; LDA(At, 0, 0); STA(SA(1, 1), 1, t + 1);
      WAIT_L(8); BAR; WAIT_L(0); MMA(0, 0, At, B0); BAR; SCHED;
      LDB(B1, 0, 1); STB(SB(0, 0), 0, t + 2);
      BAR; WAIT_L(0); MMA(0, 1, At, B1); BAR;
      LDA(At, 0, 1); STA(SA(0, 0), 0, t + 2);
      BAR; WAIT_L(0); MMA(1, 0, At, B0); BAR; SCHED;
      STB(SB(0, 1), 1, t + 2);
      WAIT_V(6); BAR; MMA(1, 1, At, B1); BAR;
      LDB(B0, 1, 0); SCHED; LDA(At, 1, 0); STA(SA(0, 1), 1, t + 2);
      WAIT_L(8); BAR; WAIT_L(0); MMA(0, 0, At, B0); BAR; SCHED;
      LDB(B1, 1, 1); STB(SB(1, 0), 0, t + 3);
      BAR; WAIT_L(0); MMA(0, 1, At, B1); BAR;
      LDA(At, 1, 1); STA(SA(1, 0), 0, t + 3);
      BAR; WAIT_L(0); MMA(1, 0, At, B0); BAR; SCHED;
      STB(SB(1, 1), 1, t + 3);
      WAIT_V(6); BAR; MMA(1, 1, At, B1); BAR;
    }
    { LDB(B0, 0, 0); LDA(At, 0, 0); STA(SA(1, 1), 1, nt - 1);
      BAR; WAIT_L(0); MMA(0, 0, At, B0); BAR;
      LDB(B1, 0, 1); BAR; WAIT_L(0); MMA(0, 1, At, B1); BAR;
      LDA(At, 0, 1); WAIT_V(4); BAR; WAIT_L(0); MMA(1, 0, At, B0); MMA(1, 1, At, B1); BAR; }
    { LDB(B0, 1, 0); LDA(At, 1, 0); WAIT_V(2); BAR; WAIT_L(0); MMA(0, 0, At, B0); BAR;
      LDB(B1, 1, 1); WAIT_V(0); BAR; WAIT_L(0); MMA(0, 1, At, B1); BAR;
      LDA(At, 1, 1); BAR; WAIT_L(0); MMA(1, 0, At, B0); MMA(1, 1, At, B1); BAR; }
    if (wr == 0) BAR;
    {
      int pm2 = pm, pn2 = pn, sub2 = sub + 1;
      if (sub2 == nsub) { sub2 = 0; ++rnd; have = tile_order(rnd * gridDim.x + blockIdx.x, 64, nN, pm2, pn2); }
      if (have) {
        cA = (const char*)(A + sub2 * asub + pn2 * acs) + (size_t)pm2 * 256 * lda * 2;
        cB = (const char*)(Bt + sub2 * bsub) + (size_t)pn2 * 256 * ldb * 2;
        ISSUE_PROLOGUE();
      }
      pm = pm2; pn = pn2; sub = sub2;
    }
    char* ws = p->ws;
    int cl = wc * 32 + 8 * fq; asm volatile("" : "+v"(cl));
    int fr_e = fr; asm volatile("" : "+v"(fr_e));
    if (kind == EPI_IN) {
      const bool isgate = ocol >= PROJ_W;
      bf16_t* obase = isgate ? (bf16_t*)(ws + OFF_GATES) + (ocol - PROJ_W) : (bf16_t*)(ws + OFF_PROJ) + ocol;
      const int old = isgate ? GATE_LD : PROJ_LD;
#pragma unroll
      for (int ai = 0; ai < 2; ++ai)
#pragma unroll
        for (int m = 0; m < 4; ++m) {
          const int rl = ai * HALF + wr * 64 + m * 16 + fr_e;
          const float rs = rsl[rl];
          bf16_t* rowp = obase + (size_t)(brow + rl) * old + cl;
#pragma unroll
          for (int bj = 0; bj < 2; ++bj) {
            f32x4 v0 = acc[ai][bj][m][0] * rs, v1 = acc[ai][bj][m][1] * rs;
            if (isgate) {
#pragma unroll
              for (int j = 0; j < 4; ++j) { v0[j] = __builtin_amdgcn_rcpf(1.f + fexp2(-LOG2E * v0[j])); v1[j] = __builtin_amdgcn_rcpf(1.f + fexp2(-LOG2E * v1[j])); }
            }
            u32x4 o; o[0] = pk_bf16(v0[0], v0[1]); o[1] = pk_bf16(v0[2], v0[3]); o[2] = pk_bf16(v1[0], v1[1]); o[3] = pk_bf16(v1[2], v1[3]);
            *(u32x4*)(rowp + bj * HALF) = o;
          }
        }
      if (ocol >= 1024 && ocol < 2048) {
        float* kb2 = (float*)(ws + OFF_KBAR) + ((size_t)(brow >> 8) * 2 + wr) * 1024 + (ocol - 1024) + cl;
#pragma unroll
        for (int bj = 0; bj < 2; ++bj)
#pragma unroll
          for (int n = 0; n < 2; ++n) {
            f32x4 s = {0.f, 0.f, 0.f, 0.f};
#pragma unroll
            for (int ai = 0; ai < 2; ++ai)
#pragma unroll
              for (int m = 0; m < 4; ++m) s += acc[ai][bj][m][n] * rsl[ai * HALF + wr * 64 + m * 16 + fr_e];
#pragma unroll
            for (int j = 0; j < 4; ++j) { float t = s[j]; t += __shfl_xor(t, 1); t += __shfl_xor(t, 2); t += __shfl_xor(t, 4); t += __shfl_xor(t, 8); s[j] = t; }
            if (fr_e == 0) *(f32x4*)(kb2 + bj * HALF + 4 * n) = s;
          }
      }
    } else if (kind == EPI_POOL) {
      bf16_t* obase = (bf16_t*)(ws + OFF_Y) + ocol;
#pragma unroll
      for (int ai = 0; ai < 2; ++ai)
#pragma unroll
        for (int m = 0; m < 4; ++m) {
          const int rl = ai * HALF + wr * 64 + m * 16 + fr_e;
          bf16_t* rowp = obase + (size_t)(brow + rl) * Y_LD + cl;
#pragma unroll
          for (int bj = 0; bj < 2; ++bj) {
            const f32x4 v0 = acc[ai][bj][m][0], v1 = acc[ai][bj][m][1];
            u32x4 o; o[0] = pk_bf16(v0[0], v0[1]); o[1] = pk_bf16(v0[2], v0[3]); o[2] = pk_bf16(v1[0], v1[1]); o[3] = pk_bf16(v1[2], v1[3]);
            *(u32x4*)(rowp + bj * HALF) = o;
          }
        }
    } else if (kind == EPI_BR) {
      const bf16_t* gbase = (const bf16_t*)(ws + OFF_GATES) + aux * DM + ocol;
      bf16_t* mbase = (bf16_t*)(ws + OFF_PROJ) + ocol;
#pragma unroll
      for (int ai = 0; ai < 2; ++ai) {
        u32x4 gg[4][2], mm[4][2];
#pragma unroll
        for (int m = 0; m < 4; ++m) {
          const int rl = ai * HALF + wr * 64 + m * 16 + fr_e;
          const bf16_t* grow = gbase + (size_t)(brow + rl) * GATE_LD + cl;
          const bf16_t* mrow = mbase + (size_t)(brow + rl) * M_LD + cl;
#pragma unroll
          for (int bj = 0; bj < 2; ++bj) {
            gg[m][bj] = *(const u32x4*)(grow + bj * HALF);
            mm[m][bj] = (aux != 0) ? *(const u32x4*)(mrow + bj * HALF) : (u32x4){0u, 0u, 0u, 0u};
          }
        }
#pragma unroll
        for (int m = 0; m < 4; ++m) {
          const int rl = ai * HALF + wr * 64 + m * 16 + fr_e;
          bf16_t* mrow = mbase + (size_t)(brow + rl) * M_LD + cl;
#pragma unroll
          for (int bj = 0; bj < 2; ++bj) {
            const u32x4 g = gg[m][bj], mo = mm[m][bj];
            f32x4 v0 = acc[ai][bj][m][0], v1 = acc[ai][bj][m][1];
            v0[0] = v0[0] * bflo(g[0]) + bflo(mo[0]); v0[1] = v0[1] * bfhi(g[0]) + bfhi(mo[0]); v0[2] = v0[2] * bflo(g[1]) + bflo(mo[1]); v0[3] = v0[3] * bfhi(g[1]) + bfhi(mo[1]);
            v1[0] = v1[0] * bflo(g[2]) + bflo(mo[2]); v1[1] = v1[1] * bfhi(g[2]) + bfhi(mo[2]); v1[2] = v1[2] * bflo(g[3]) + bflo(mo[3]); v1[3] = v1[3] * bfhi(g[3]) + bfhi(mo[3]);
            u32x4 o; o[0] = pk_bf16(v0[0], v0[1]); o[1] = pk_bf16(v0[2], v0[3]); o[2] = pk_bf16(v1[0], v1[1]); o[3] = pk_bf16(v1[2], v1[3]);
            *(u32x4*)(mrow + bj * HALF) = o;
          }
        }
      }
    } else if (kind == EPI_RES) {
      bf16_t* xb = (bf16_t*)(ws + OFF_XB) + ocol;
      float* ssq = (float*)(ws + OFF_SSQ);
      const int pslot = (ocol >> 8) * 4 + wc;
#pragma unroll
      for (int ai = 0; ai < 2; ++ai) {
        u32x4 hh[4][2];
#pragma unroll
        for (int m = 0; m < 4; ++m) {
          const int rl = ai * HALF + wr * 64 + m * 16 + fr_e;
          const bf16_t* xr = xb + (size_t)(brow + rl) * XB_LD + cl;
#pragma unroll
          for (int bj = 0; bj < 2; ++bj) hh[m][bj] = *(const u32x4*)(xr + bj * HALF);
        }
#pragma unroll
        for (int m = 0; m < 4; ++m) {
          const int rl = ai * HALF + wr * 64 + m * 16 + fr_e;
          bf16_t* xr = xb + (size_t)(brow + rl) * XB_LD + cl;
          float s = 0.f;
#pragma unroll
          for (int bj = 0; bj < 2; ++bj) {
            const u32x4 h = hh[m][bj];
            f32x4 v0 = acc[ai][bj][m][0], v1 = acc[ai][bj][m][1];
            v0[0] += bflo(h[0]); v0[1] += bfhi(h[0]); v0[2] += bflo(h[1]); v0[3] += bfhi(h[1]);
            v1[0] += bflo(h[2]); v1[1] += bfhi(h[2]); v1[2] += bflo(h[3]); v1[3] += bfhi(h[3]);
            s += v0[0] * v0[0] + v0[1] * v0[1] + v0[2] * v0[2] + v0[3] * v0[3] + v1[0] * v1[0] + v1[1] * v1[1] + v1[2] * v1[2] + v1[3] * v1[3];
            u32x4 o; o[0] = pk_bf16(v0[0], v0[1]); o[1] = pk_bf16(v0[2], v0[3]); o[2] = pk_bf16(v1[0], v1[1]); o[3] = pk_bf16(v1[2], v1[3]);
            *(u32x4*)(xr + bj * HALF) = o;
          }
          s += __shfl_xor(s, 16); s += __shfl_xor(s, 32);
          if (fq == 0) ssq[(size_t)(brow + rl) * 32 + pslot] = s;
        }
      }
    } else {
      bf16_t* abase = (bf16_t*)(ws + OFF_PROJ) + ocol;
#pragma unroll
      for (int ai = 0; ai < 2; ++ai)
#pragma unroll
        for (int m = 0; m < 4; ++m) {
          const int rl = ai * HALF + wr * 64 + m * 16 + fr_e;
          const float rs = rsl[rl];
          bf16_t* rowp = abase + (size_t)(brow + rl) * ACT_LD + cl;
          f32x4 v[2];
#pragma unroll
          for (int n = 0; n < 2; ++n) {
            const f32x4 g = acc[ai][0][m][n] * rs, u = acc[ai][1][m][n] * rs;
#pragma unroll
            for (int j = 0; j < 4; ++j) v[n][j] = g[j] * __builtin_amdgcn_rcpf(1.f + fexp2(-LOG2E * g[j])) * u[j];
          }
          u32x4 o; o[0] = pk_bf16(v[0][0], v[0][1]); o[1] = pk_bf16(v[0][2], v[0][3]); o[2] = pk_bf16(v[1][0], v[1][1]); o[3] = pk_bf16(v[1][2], v[1][3]);
          *(u32x4*)rowp = o;
        }
    }
  }
}

DI void branch_phase(KParams p, char* shmc) {
  LAS unsigned char* lds = (LAS unsigned char*)shmc;
  const int tid = opaque_tid();
  const int wid = __builtin_amdgcn_readfirstlane(tid >> 6), lane = tid & 63, wr = wid >> 2, wc = wid & 3, fr = lane & 15, fq = lane >> 4;
  const int lda = Y_LD, ldb = 1024;
  unsigned voffA[2], voffB[2];
#pragma unroll
  for (int i = 0; i < 2; ++i) { int R, C; stage_rc(tid * 16 + i * 8192, R, C); voffA[i] = (unsigned)(R * lda + C) * 2u; voffB[i] = (unsigned)(R * ldb + C) * 2u; }
  const unsigned ldsw = (unsigned)wid * 1024u;
  const int aoff = lds_byte(wr * 64 + fr, fq * 8), boff = lds_byte(wc * 32 + fr, fq * 8);
  const size_t hA = (size_t)HALF * lda * 2, hB = (size_t)HALF * ldb * 2;
  char* ws = p->ws;
  const bf16_t* Y = (const bf16_t*)(ws + OFF_Y); const bf16_t* W = (const bf16_t*)(ws + OFF_WBR);
  int pm, pn, rnd = 0;
  if (!tile_order(blockIdx.x, 64, 8, pm, pn)) return;
  const char* cA = (const char*)Y + (size_t)pm * 256 * lda * 2;
  const char* cB = (const char*)W + (size_t)pn * 256 * ldb * 2;
  __syncthreads();
  ISSUE_PROLOGUE();
  const int nt = 16;
  bool have = true;
  while (have) {
    const int brow = pm * 256, ocol = pn * 256;
    int pm2 = pm, pn2 = pn;
    f32x4 acc[2][2][4][2];
#pragma unroll
    for (int a = 0; a < 2; ++a)
#pragma unroll
      for (int b = 0; b < 2; ++b)
#pragma unroll
        for (int m = 0; m < 4; ++m)
#pragma unroll
          for (int n = 0; n < 2; ++n) acc[a][b][m][n] = (f32x4){0.f, 0.f, 0.f, 0.f};
#pragma unroll 1
    for (int br = 0; br < 3; ++br) {
      bf16x8 At[4][2], B0[2][2], B1[2][2];
      if (wr == 1) BAR;
      WAIT_V(10); BAR;
      WAIT_V(6); BAR;
      for (int t = 0; t < nt - 2; t += 2) {
        LDB(B0, 0, 0); SCHED; LDA(At, 0, 0); STA(SA(1, 1), 1, t + 1);
        WAIT_L(8); BAR; WAIT_L(0); MMA(0, 0, At, B0); BAR; SCHED;
        LDB(B1, 0, 1); STB(SB(0, 0), 0, t + 2);
        BAR; WAIT_L(0); MMA(0, 1, At, B1); BAR;
        LDA(At, 0, 1); STA(SA(0, 0), 0, t + 2);
        BAR; WAIT_L(0); MMA(1, 0, At, B0); BAR; SCHED;
        STB(SB(0, 1), 1, t + 2);
        WAIT_V(6); BAR; MMA(1, 1, At, B1); BAR;
        LDB(B0, 1, 0); SCHED; LDA(At, 1, 0); STA(SA(0, 1), 1, t + 2);
        WAIT_L(8); BAR; WAIT_L(0); MMA(0, 0, At, B0); BAR; SCHED;
        LDB(B1, 1, 1); STB(SB(1, 0), 0, t + 3);
        BAR; WAIT_L(0); MMA(0, 1, At, B1); BAR;
        LDA(At, 1, 1); STA(SA(1, 0), 0, t + 3);
        BAR; WAIT_L(0); MMA(1, 0, At, B0); BAR; SCHED;
        STB(SB(1, 1), 1, t + 3);
        WAIT_V(6); BAR; MMA(1, 1, At, B1); BAR;
      }
      { LDB(B0, 0, 0); LDA(At, 0, 0); STA(SA(1, 1), 1, nt - 1);
        BAR; WAIT_L(0); MMA(0, 0, At, B0); BAR;
        LDB(B1, 0, 1); BAR; WAIT_L(0); MMA(0, 1, At, B1); BAR;
        LDA(At, 0, 1); WAIT_V(4); BAR; WAIT_L(0); MMA(1, 0, At, B0); MMA(1, 1, At, B1); BAR; }
      { LDB(B0, 1, 0); LDA(At, 1, 0); WAIT_V(2); BAR; WAIT_L(0); MMA(0, 0, At, B0); BAR;
        LDB(B1, 1, 1); WAIT_V(0); BAR; WAIT_L(0); MMA(0, 1, At, B1); BAR;
        LDA(At, 1, 1); BAR; WAIT_L(0); MMA(1, 0, At, B0); MMA(1, 1, At, B1); BAR; }
      if (wr == 0) BAR;
      if (br < 2) {
        cA = (const char*)(Y + (br + 1) * 1024) + (size_t)pm * 256 * lda * 2;
        cB = (const char*)(W + (size_t)(br + 1) * (SZ_WBR1 / 2)) + (size_t)pn * 256 * ldb * 2;
        ISSUE_PROLOGUE();
      } else {
        ++rnd; have = tile_order(rnd * gridDim.x + blockIdx.x, 64, 8, pm2, pn2);
        if (have) { cA = (const char*)Y + (size_t)pm2 * 256 * lda * 2; cB = (const char*)W + (size_t)pn2 * 256 * ldb * 2; ISSUE_PROLOGUE(); }
      }
      int lane2 = __builtin_amdgcn_mbcnt_hi(~0u, __builtin_amdgcn_mbcnt_lo(~0u, 0u)); asm volatile("" : "+v"(lane2));
      const int cl = wc * 32 + 8 * (lane2 >> 4), fr_e = lane2 & 15;
      const bf16_t* gcur = (const bf16_t*)(ws + OFF_GATES) + br * DM + ocol;
      const bf16_t* gnxt = gcur + DM;
      bf16_t* mbase = (bf16_t*)(ws + OFF_PROJ) + ocol;
#pragma unroll
      for (int ai = 0; ai < 2; ++ai)
#pragma unroll
        for (int mh = 0; mh < 2; ++mh) {
          u32x4 gg[2][2], gn[2][2];
#pragma unroll
          for (int m2 = 0; m2 < 2; ++m2) {
            const int rl = ai * HALF + wr * 64 + (mh * 2 + m2) * 16 + fr_e;
            const size_t go = (size_t)(brow + rl) * GATE_LD + cl;
#pragma unroll
            for (int bj = 0; bj < 2; ++bj) {
              gg[m2][bj] = *(const u32x4*)(gcur + go + bj * HALF);
              if (br < 2) gn[m2][bj] = *(const u32x4*)(gnxt + go + bj * HALF);
            }
          }
#pragma unroll
          for (int m2 = 0; m2 < 2; ++m2) {
            const int m = mh * 2 + m2;
            const int rl = ai * HALF + wr * 64 + m * 16 + fr_e;
            bf16_t* mrow = mbase + (size_t)(brow + rl) * M_LD + cl;
#pragma unroll
            for (int bj = 0; bj < 2; ++bj) {
              const u32x4 g = gg[m2][bj];
              f32x4 v0 = acc[ai][bj][m][0], v1 = acc[ai][bj][m][1];
              if (br < 2) {
                const u32x4 d = gn[m2][bj];
                v0[0] *= bflo(g[0]) * __builtin_amdgcn_rcpf(fmaxf(bflo(d[0]), 1e-20f)); v0[1] *= bfhi(g[0]) * __builtin_amdgcn_rcpf(fmaxf(bfhi(d[0]), 1e-20f));
                v0[2] *= bflo(g[1]) * __builtin_amdgcn_rcpf(fmaxf(bflo(d[1]), 1e-20f)); v0[3] *= bfhi(g[1]) * __builtin_amdgcn_rcpf(fmaxf(bfhi(d[1]), 1e-20f));
                v1[0] *= bflo(g[2]) * __builtin_amdgcn_rcpf(fmaxf(bflo(d[2]), 1e-20f)); v1[1] *= bfhi(g[2]) * __builtin_amdgcn_rcpf(fmaxf(bfhi(d[2]), 1e-20f));
                v1[2] *= bflo(g[3]) * __builtin_amdgcn_rcpf(fmaxf(bflo(d[3]), 1e-20f)); v1[3] *= bfhi(g[3]) * __builtin_amdgcn_rcpf(fmaxf(bfhi(d[3]), 1e-20f));
                acc[ai][bj][m][0] = v0; acc[ai][bj][m][1] = v1;
              } else {
                v0[0] *= fmaxf(bflo(g[0]), 1e-20f); v0[1] *= fmaxf(bfhi(g[0]), 1e-20f); v0[2] *= fmaxf(bflo(g[1]), 1e-20f); v0[3] *= fmaxf(bfhi(g[1]), 1e-20f);
                v1[0] *= fmaxf(bflo(g[2]), 1e-20f); v1[1] *= fmaxf(bfhi(g[2]), 1e-20f); v1[2] *= fmaxf(bflo(g[3]), 1e-20f); v1[3] *= fmaxf(bfhi(g[3]), 1e-20f);
                u32x4 o; o[0] = pk_bf16(v0[0], v0[1]); o[1] = pk_bf16(v0[2], v0[3]); o[2] = pk_bf16(v1[0], v1[1]); o[3] = pk_bf16(v1[2], v1[3]);
                *(u32x4*)(mrow + bj * HALF) = o;
              }
            }
          }
        }
    }
    pm = pm2; pn = pn2;
  }
}

constexpr int KP = 272, VP = 320, KBUF = 64 * KP, VBUF = 64 * VP;
constexpr int AT_V = 3 * KBUF, AT_BT = AT_V + 3 * VBUF, AT_KB = AT_BT + 16384, AT_SM = AT_KB + 8192, AT_FL = AT_SM + 1024;

DI int rel_bucket_i(int n) {
  if (n < 16) return n;
  return 16 + (n >= 22) + (n >= 30) + (n >= 40) + (n >= 54) + (n >= 73) + (n >= 99) + (n >= 134) + (n >= 182) + (n >= 246) + (n >= 332) + (n >= 450) + (n >= 609) + (n >= 825) + (n >= 1117) + (n >= 1513);
}

template <int MODE> DI void attn_unit(KParams p, int b, int h, int qt, char* shm) {
  const int tid = opaque_tid(), lane = tid & 63, w = __builtin_amdgcn_readfirstlane(tid >> 6), r = lane & 31, hh = lane >> 5;
  const bf16_t* proj = (const bf16_t*)(p->ws + OFF_PROJ);
  const int qcol = (MODE == 0 ? 0 : 4096) + h * 128, kcol = qcol + 1024, vcol = qcol + 2048;
  const size_t tok0 = (size_t)b * SEQ;
  const int q0 = qt * 256, q0w = q0 + 32 * w, qpos = q0w + r;
  const float SC = 0.08838834764831845f * LOG2E;
  float* btab = (float*)(shm + AT_BT);
  int* flags = (int*)(shm + AT_FL);
  __syncthreads();
  bf16x8 qf[8];
  { const bf16_t* qp = proj + (tok0 + qpos) * PROJ_LD + qcol + 8 * hh;
#pragma unroll
    for (int s = 0; s < 8; ++s) qf[s] = *(const bf16x8*)(qp + 16 * s); }
  unsigned mymask = 0;
  if (MODE == 0) {
    float* kbl = (float*)(shm + AT_KB); unsigned* selm = (unsigned*)(shm + AT_SM);
    { const int kblk = tid >> 5, part = tid & 31;
      const float* kbg = (const float*)(p->ws + OFF_KBAR) + ((size_t)(b * 16 + kblk) * 2) * 1024 + h * 128 + part * 4;
      const f32x4 k0 = *(const f32x4*)kbg, k1 = *(const f32x4*)(kbg + 1024);
      *(f32x4*)(kbl + kblk * 128 + part * 4) = (k0 + k1) * (1.f / 256.f); }
#pragma unroll
    for (int i = 0; i < 8; ++i) { const int d = tid + 512 * i; btab[d] = p->rel_bias[h * 32 + rel_bucket_i(d)] * LOG2E; }
    __syncthreads();
    const int ql = tid >> 1, half = tid & 1, own = qt;
    float g[8] = {0.f, 0.f, 0.f, 0.f, 0.f, 0.f, 0.f, 0.f};
    if (own > 0) {
      const bf16_t* qp = proj + (tok0 + q0 + ql) * PROJ_LD + qcol;
#pragma unroll 2
      for (int dc = 0; dc < 16; ++dc) {
        const u32x4 qv = *(const u32x4*)(qp + dc * 8);
        float qq[8];
#pragma unroll
        for (int e = 0; e < 4; ++e) { qq[2 * e] = bflo(qv[e]); qq[2 * e + 1] = bfhi(qv[e]); }
#pragma unroll
        for (int n = 0; n < 8; ++n) {
          const float* kr = kbl + (half * 8 + n) * 128 + dc * 8;
          const f32x4 k0 = *(const f32x4*)kr, k1 = *(const f32x4*)(kr + 4);
          g[n] += qq[0] * k0[0] + qq[1] * k0[1] + qq[2] * k0[2] + qq[3] * k0[3] + qq[4] * k1[0] + qq[5] * k1[1] + qq[6] * k1[2] + qq[7] * k1[3];
        }
      }
    }
    float all[16];
#pragma unroll
    for (int n = 0; n < 8; ++n) { const float go = __shfl_xor(g[n], 1); all[n] = half ? go : g[n]; all[8 + n] = half ? g[n] : go; }
    unsigned mask = 1u << own;
    const int nsel = own < 3 ? own : 3;
#pragma unroll
    for (int t = 0; t < 3; ++t) {
      if (t < nsel) {
        float best = -3.0e38f; int bi = 0;
#pragma unroll
        for (int n = 0; n < 16; ++n) { const bool ok = (n < own) && !((mask >> n) & 1u) && (all[n] > best); best = ok ? all[n] : best; bi = ok ? n : bi; }
        mask |= 1u << bi;
      }
    }
    if (half == 0) selm[ql] = mask;
    __syncthreads();
    mymask = selm[32 * w + r];
  } else {
    if (tid < 16) flags[tid] = 0;
  }
  bf16x8 tf[2];
  if (MODE == 1) {
#pragma unroll
    for (int s = 0; s < 2; ++s)
#pragma unroll
      for (int j = 0; j < 8; ++j) { const int k = 16 * s + 8 * (j >> 2) + 4 * hh + (j & 3); tf[s][j] = (k >= r) ? (short)0x3F80 : (short)0; }
  }
  f32x16 o[4];
#pragma unroll
  for (int dt = 0; dt < 4; ++dt)
#pragma unroll
    for (int i = 0; i < 16; ++i) o[dt][i] = 0.f;
  float mrun = -1e30f, lrun = 0.f, carry = 0.f;
  const int ntiles = 4 * qt + 4;
  u32x4 kreg[2], vreg[2];
#define GLOAD(kst) do { _Pragma("unroll") for (int _i = 0; _i < 2; ++_i) { const int _c = tid + 512 * _i, _key = _c >> 4, _part = _c & 15; \
      const bf16_t* _rp = proj + (tok0 + (kst) + _key) * PROJ_LD; kreg[_i] = *(const u32x4*)(_rp + kcol + _part * 8); vreg[_i] = *(const u32x4*)(_rp + vcol + _part * 8); } } while (0)
#define LSTORE(buf) do { _Pragma("unroll") for (int _i = 0; _i < 2; ++_i) { const int _c = tid + 512 * _i, _key = _c >> 4, _part = _c & 15; \
      *(u32x4*)(shm + (buf) * KBUF + _key * KP + _part * 16) = kreg[_i]; *(u32x4*)(shm + AT_V + (buf) * VBUF + _key * VP + _part * 16) = vreg[_i]; } } while (0)
#define KST(it) (MODE == 0 ? 64 * (it) : 64 * (ntiles - 1 - (it)))
  GLOAD(KST(0)); LSTORE(0); __syncthreads();
  const int i16 = lane & 15, q4 = i16 >> 2, p4 = i16 & 3, blk16 = (lane >> 4) & 1;
  bool wdone = false;
  const bool defer = (MODE == 0) && (w >= 4);
  bf16x8 pf[4]; bool pend = false; int pendbuf = 0;
#pragma unroll
  for (int ks = 0; ks < 4; ++ks) pf[ks] = (bf16x8){0, 0, 0, 0, 0, 0, 0, 0};
#define PV_STEP(PF, B) do { const char* _vb0 = shm + AT_V + (B) * VBUF + (4 * hh + q4) * VP + 32 * blk16 + 8 * p4; \
    _Pragma("unroll") for (int dt = 0; dt < 4; ++dt) _Pragma("unroll") for (int ks = 0; ks < 4; ++ks) { \
      const char* _vb = _vb0 + (ks * 16) * VP + dt * 64; \
      const s16x4 _lo = __builtin_amdgcn_ds_read_tr16_b64_v4i16((LAS s16x4*)(_vb)); \
      const s16x4 _hi = __builtin_amdgcn_ds_read_tr16_b64_v4i16((LAS s16x4*)(_vb + 8 * VP)); \
      o[dt] = mfma32(__builtin_shufflevector(_lo, _hi, 0, 1, 2, 3, 4, 5, 6, 7), PF[ks], o[dt]); } } while (0)
  int buf = 0;
  for (int it = 0; it < ntiles; ++it) {
    const int kst = KST(it), nbuf = (buf == 2) ? 0 : buf + 1;
    if (MODE == 1 && it > 0) {
      const int* fl = flags + ((it - 1) & 1) * 8;
      const int alld = fl[0] & fl[1] & fl[2] & fl[3] & fl[4] & fl[5] & fl[6] & fl[7];
      if (alld) break;
    }
    if (it + 1 < ntiles) GLOAD(KST(it + 1));
    if (defer && pend) { PV_STEP(pf, pendbuf); pend = false; }
    bool active;
    bool sel = true;
    if (MODE == 0) {
      const int j = kst >> 8;
      if (j == qt) active = (kst - q0) <= 32 * w + 31;
      else { sel = (mymask >> j) & 1u; active = __builtin_amdgcn_ballot_w64(sel) != 0ull; }
    } else {
      active = !wdone && (kst <= q0w + 31);
    }
    if (active) {
      f32x16 st[2];
#pragma unroll
      for (int sub = 0; sub < 2; ++sub) {
        f32x16 a16;
#pragma unroll
        for (int i = 0; i < 16; ++i) a16[i] = 0.f;
        const char* kb = shm + buf * KBUF + (sub * 32 + r) * KP + hh * 16;
#pragma unroll
        for (int s = 0; s < 8; ++s) a16 = mfma32(*(const bf16x8*)(kb + s * 32), qf[s], a16);
        st[sub] = a16;
      }
      if (MODE == 0) {
        __builtin_amdgcn_s_setprio(1);
        float mx = -1e30f;
        const int dmin = q0w - (kst + 63), dmax = q0w + 31 - kst;
        const int bl = rel_bucket_i(dmin < 0 ? 0 : dmin), bh = rel_bucket_i(dmax);
        if ((kst >> 8) != qt && dmin >= 16 && bh - bl <= 1) {
          int T = 1513;
          if (dmin < 1117) T = 1117; if (dmin < 825) T = 825; if (dmin < 609) T = 609; if (dmin < 450) T = 450; if (dmin < 332) T = 332;
          if (dmin < 246) T = 246; if (dmin < 182) T = 182; if (dmin < 134) T = 134; if (dmin < 99) T = 99; if (dmin < 73) T = 73;
          if (dmin < 54) T = 54; if (dmin < 40) T = 40; if (dmin < 30) T = 30; if (dmin < 22) T = 22;
          if (bh == bl) T = -(1 << 30);
          const float bhi = btab[dmax], blo = btab[dmin];
          const float hi_l = sel ? bhi : -1e30f, lo_l = sel ? blo : -1e30f;
          const int dist0 = qpos - kst - 4 * hh;
#pragma unroll
          for (int sub = 0; sub < 2; ++sub)
#pragma unroll
            for (int i = 0; i < 16; ++i) {
              const int c = sub * 32 + (i & 3) + 8 * (i >> 2);
              const float bias = (dist0 >= T + c) ? hi_l : lo_l;
              const float v = st[sub][i] * SC + bias;
              st[sub][i] = v; mx = fmaxf(mx, v);
            }
        } else {
#pragma unroll
          for (int sub = 0; sub < 2; ++sub)
#pragma unroll
            for (int i = 0; i < 16; ++i) {
              const int key = kst + sub * 32 + (i & 3) + 8 * (i >> 2) + 4 * hh;
              const int dist = qpos - key;
              const bool valid = sel && (dist >= 0);
              const float bias = btab[dist < 0 ? 0 : dist];
              const float v = valid ? st[sub][i] * SC + bias : -1e30f;
              st[sub][i] = v; mx = fmaxf(mx, v);
            }
        }
        mx = fmaxf(mx, __shfl_xor(mx, 32));
        const float mnew = (mx > mrun + 8.f) ? mx : mrun;
        float ps = 0.f;
#pragma unroll
        for (int sub = 0; sub < 2; ++sub)
#pragma unroll
          for (int i = 0; i < 16; ++i) { const float pv = fexp2(st[sub][i] - mnew); st[sub][i] = pv; ps += pv; }
        if (__builtin_amdgcn_ballot_w64(mnew > mrun) != 0ull) {
          const float alpha = fexp2(mrun - mnew);
          mrun = mnew;
          lrun *= alpha;
#pragma unroll
          for (int dt = 0; dt < 4; ++dt)
#pragma unroll
            for (int i = 0; i < 16; ++i) o[dt][i] *= alpha;
        }
        lrun += ps;
        __builtin_amdgcn_s_setprio(0);
      } else {
#pragma unroll
        for (int sub = 1; sub >= 0; --sub) {
          f32x16 sp;
#pragma unroll
          for (int i = 0; i < 16; ++i) {
            const int key = kst + sub * 32 + (i & 3) + 8 * (i >> 2) + 4 * hh;
            const bool valid = key < qpos;
            const float z = st[sub][i] * SC;
            const float s = fmaxf(z, 0.f) + flog2(1.f + fexp2(-fabsf(z)));
            sp[i] = valid ? s : 0.f; st[sub][i] = z;
          }
          f32x16 c;
#pragma unroll
          for (int i = 0; i < 16; ++i) c[i] = carry;
#pragma unroll
          for (int s2 = 0; s2 < 2; ++s2) {
            u32x4 hi, lo;
#pragma unroll
            for (int jj = 0; jj < 4; ++jj) {
              const float a0 = sp[8 * s2 + 2 * jj], a1 = sp[8 * s2 + 2 * jj + 1];
              const unsigned hv = pk_bf16(a0, a1);
              hi[jj] = hv; lo[jj] = pk_bf16(a0 - bflo(hv), a1 - bfhi(hv));
            }
            c = mfma32(tf[s2], __builtin_bit_cast(bf16x8, hi), c);
            c = mfma32(tf[s2], __builtin_bit_cast(bf16x8, lo), c);
          }
          carry = __shfl(c[0], r);
#pragma unroll
          for (int i = 0; i < 16; ++i) {
            const int key = kst + sub * 32 + (i & 3) + 8 * (i >> 2) + 4 * hh;
            const bool valid = key < qpos;
            st[sub][i] = valid ? fexp2(st[sub][i] - c[i]) : 0.f;
          }
        }
        wdone = __builtin_amdgcn_ballot_w64(carry > 152.f) == ~0ull;
      }
#pragma unroll
      for (int ks = 0; ks < 4; ++ks) {
        u32x4 t;
#pragma unroll
        for (int jj = 0; jj < 4; ++jj) t[jj] = pk_bf16(st[ks >> 1][8 * (ks & 1) + 2 * jj], st[ks >> 1][8 * (ks & 1) + 2 * jj + 1]);
        pf[ks] = __builtin_bit_cast(bf16x8, t);
      }
      if (!defer) { PV_STEP(pf, buf); }
      else { pend = true; pendbuf = buf; }
    }
    if (MODE == 1) { if (lane == 0) flags[(it & 1) * 8 + w] = (wdone || (kst == 0)) ? 1 : 0; }
    if (it + 1 < ntiles) LSTORE(nbuf);
    __syncthreads();
    buf = nbuf;
  }
  if (defer && pend) { PV_STEP(pf, pendbuf); }
#undef PV_STEP
  float inv = 1.f;
  if (MODE == 0) { const float lt = lrun + __shfl_xor(lrun, 32); inv = 1.f / lt; }
  bf16_t* yp = (bf16_t*)(p->ws + OFF_Y) + (tok0 + qpos) * Y_LD + (MODE == 0 ? 0 : 2048) + h * 128 + 4 * hh;
#pragma unroll
  for (int dt = 0; dt < 4; ++dt)
#pragma unroll
    for (int g = 0; g < 4; ++g) {
      u32x2 ov; ov[0] = pk_bf16(o[dt][4 * g] * inv, o[dt][4 * g + 1] * inv); ov[1] = pk_bf16(o[dt][4 * g + 2] * inv, o[dt][4 * g + 3] * inv);
      *(u32x2*)(yp + dt * 32 + 8 * g) = ov;
    }
#undef GLOAD
#undef LSTORE
#undef KST
}

constexpr int SBW_K = 32 * KP, SBW_V = 32 * VP, SBW_LDS = SBW_K + SBW_V;
DI void sb_unit(KParams p, int b, int h, int qt, char* shm) {
  const int tid = opaque_tid(), lane = tid & 63, w = __builtin_amdgcn_readfirstlane(tid >> 6), r = lane & 31, hh = lane >> 5;
  const bf16_t* proj = (const bf16_t*)(p->ws + OFF_PROJ);
  const int qcol = 4096 + h * 128, kcol = qcol + 1024, vcol = qcol + 2048;
  const size_t tok0 = (size_t)b * SEQ;
  const int q0w = qt * 256 + 32 * w, qpos = q0w + r;
  const float SC = 0.08838834764831845f * LOG2E;
  char* kl = shm + w * SBW_LDS; char* vl = kl + SBW_K;
  __syncthreads();
  bf16x8 qf[8];
  { const bf16_t* qp = proj + (tok0 + qpos) * PROJ_LD + qcol + 8 * hh;
#pragma unroll
    for (int s = 0; s < 8; ++s) qf[s] = *(const bf16x8*)(qp + 16 * s); }
  bf16x8 tf[2];
#pragma unroll
  for (int s = 0; s < 2; ++s)
#pragma unroll
    for (int j = 0; j < 8; ++j) { const int k = 16 * s + 8 * (j >> 2) + 4 * hh + (j & 3); tf[s][j] = (k >= r) ? (short)0x3F80 : (short)0; }
  f32x16 o[4];
#pragma unroll
  for (int dt = 0; dt < 4; ++dt)
#pragma unroll
    for (int i = 0; i < 16; ++i) o[dt][i] = 0.f;
  float carry = 0.f;
  const int i16 = lane & 15, q4 = i16 >> 2, p4 = i16 & 3, blk16 = (lane >> 4) & 1;
  u32x4 kreg[4], vreg[4];
#define SB_GLOAD(kst) do { _Pragma("unroll") for (int _i = 0; _i < 4; ++_i) { const int _c = lane + 64 * _i, _key = _c >> 3, _part = _c & 7; \
      const bf16_t* _rp = proj + (tok0 + (kst) + _key) * PROJ_LD; kreg[_i] = *(const u32x4*)(_rp + kcol + _part * 16); vreg[_i] = *(const u32x4*)(_rp + vcol + _part * 16); } } while (0)
  u32x4 kreg2[4], vreg2[4];
#define SB_GLOAD2(kst) do { _Pragma("unroll") for (int _i = 0; _i < 4; ++_i) { const int _c = lane + 64 * _i, _key = _c >> 3, _part = _c & 7; \
      const bf16_t* _rp = proj + (tok0 + (kst) + _key) * PROJ_LD; kreg2[_i] = *(const u32x4*)(_rp + kcol + _part * 16 + 8); vreg2[_i] = *(const u32x4*)(_rp + vcol + _part * 16 + 8); } } while (0)
#define SB_LSTORE() do { _Pragma("unroll") for (int _i = 0; _i < 4; ++_i) { const int _c = lane + 64 * _i, _key = _c >> 3, _part = _c & 7; \
      *(u32x4*)(kl + _key * KP + _part * 32) = kreg[_i]; *(u32x4*)(kl + _key * KP + _part * 32 + 16) = kreg2[_i]; \
      *(u32x4*)(vl + _key * VP + _part * 32) = vreg[_i]; *(u32x4*)(vl + _key * VP + _part * 32 + 16) = vreg2[_i]; } } while (0)
  int kst = q0w;
  SB_GLOAD(kst); SB_GLOAD2(kst);
  for (;;) {
    SB_LSTORE();
    const int knext = kst - 32;
    if (knext >= 0) { SB_GLOAD(knext); SB_GLOAD2(knext); }
    f32x16 st;
#pragma unroll
    for (int i = 0; i < 16; ++i) st[i] = 0.f;
    { const char* kb = kl + r * KP + hh * 16;
#pragma unroll
      for (int s = 0; s < 8; ++s) st = mfma32(*(const bf16x8*)(kb + s * 32), qf[s], st); }
    f32x16 sp;
#pragma unroll
    for (int i = 0; i < 16; ++i) {
      const int key = kst + (i & 3) + 8 * (i >> 2) + 4 * hh;
      const float z = st[i] * SC;
      const float s = fmaxf(z, 0.f) + flog2(1.f + fexp2(-fabsf(z)));
      sp[i] = (key < qpos) ? s : 0.f; st[i] = z;
    }
    f32x16 c;
#pragma unroll
    for (int i = 0; i < 16; ++i) c[i] = carry;
#pragma unroll
    for (int s2 = 0; s2 < 2; ++s2) {
      u32x4 hi, lo;
#pragma unroll
      for (int jj = 0; jj < 4; ++jj) {
        const float a0 = sp[8 * s2 + 2 * jj], a1 = sp[8 * s2 + 2 * jj + 1];
        const unsigned hv = pk_bf16(a0, a1);
        hi[jj] = hv; lo[jj] = pk_bf16(a0 - bflo(hv), a1 - bfhi(hv));
      }
      c = mfma32(tf[s2], __builtin_bit_cast(bf16x8, hi), c);
      c = mfma32(tf[s2], __builtin_bit_cast(bf16x8, lo), c);
    }
    carry = __shfl(c[0], r);
    bf16x8 pf[2];
#pragma unroll
    for (int ks = 0; ks < 2; ++ks) {
      u32x4 t;
#pragma unroll
      for (int jj = 0; jj < 4; ++jj) {
        const int i0 = 8 * ks + 2 * jj, i1 = i0 + 1;
        const int key0 = kst + (i0 & 3) + 8 * (i0 >> 2) + 4 * hh, key1 = kst + (i1 & 3) + 8 * (i1 >> 2) + 4 * hh;
        const float a0 = (key0 < qpos) ? fexp2(st[i0] - c[i0]) : 0.f, a1 = (key1 < qpos) ? fexp2(st[i1] - c[i1]) : 0.f;
        t[jj] = pk_bf16(a0, a1);
      }
      pf[ks] = __builtin_bit_cast(bf16x8, t);
    }
    const char* vb0 = vl + (4 * hh + q4) * VP + 32 * blk16 + 8 * p4;
#pragma unroll
    for (int dt = 0; dt < 4; ++dt)
#pragma unroll
      for (int ks = 0; ks < 2; ++ks) {
        const char* vb = vb0 + (ks * 16) * VP + dt * 64;
        const s16x4 lo = __builtin_amdgcn_ds_read_tr16_b64_v4i16((LAS s16x4*)(vb));
        const s16x4 hi = __builtin_amdgcn_ds_read_tr16_b64_v4i16((LAS s16x4*)(vb + 8 * VP));
        o[dt] = mfma32(__builtin_shufflevector(lo, hi, 0, 1, 2, 3, 4, 5, 6, 7), pf[ks], o[dt]);
      }
    if (knext < 0 || __builtin_amdgcn_ballot_w64(carry > 152.f) == ~0ull) break;
    kst = knext;
  }
#undef SB_GLOAD
#undef SB_GLOAD2
#undef SB_LSTORE
  bf16_t* yp = (bf16_t*)(p->ws + OFF_Y) + (tok0 + qpos) * Y_LD + 2048 + h * 128 + 4 * hh;
#pragma unroll
  for (int dt = 0; dt < 4; ++dt)
#pragma unroll
    for (int g = 0; g < 4; ++g) {
      u32x2 ov; ov[0] = pk_bf16(o[dt][4 * g], o[dt][4 * g + 1]); ov[1] = pk_bf16(o[dt][4 * g + 2], o[dt][4 * g + 3]);
      *(u32x2*)(yp + dt * 32 + 8 * g) = ov;
    }
}

DI void attention_phase(KParams p, char* shm) {
  for (int k = blockIdx.x; k < 256; k += gridDim.x)
    for (int s = 0; s < 2; ++s) { const int u = s ? 511 - k : k; attn_unit<0>(p, (u & 31) >> 3, u & 7, 15 - (u >> 5), shm); }
  for (int k = blockIdx.x; k < 256; k += gridDim.x)
    for (int s = 0; s < 2; ++s) { const int u = s ? 511 - k : k; sb_unit(p, (u & 31) >> 3, u & 7, 15 - (u >> 5), shm); }
}

constexpr int NPHASE = 15;
DI void run_phase(KParams p, int ph, char* shm) {
  asm volatile("" : "+s"(p));
  char* ws = p->ws;
  const int l = ph == 0 ? 0 : (ph - 1) / 7, sp0 = ph == 0 ? -1 : (ph - 1) % 7, sp = sp0 >= 1 ? sp0 + 1 : sp0;
  if (ph == 0 || (sp == 7 && l == 0)) { convert_layer(p, ph == 0 ? 0 : 1, shm); if (ph == 0) x_prep(p); return; }
  if (sp == 7) { final_norm(p); return; }
  if (sp == 2) attention_phase(p, shm);
  if (sp == 3) { branch_phase(p, shm); return; }
  const bf16_t* A; const bf16_t* Bt; int lda, ldb, K, nN, kind, nsub = 1, acs = 0, oc0 = 0, ocs = 256; const float* hin = nullptr;
  size_t asub = 0, bsub = 0;
  if (sp == 0) { A = (const bf16_t*)(ws + OFF_XB); lda = XB_LD; Bt = (const bf16_t*)(ws + OFF_WIN); ldb = DM; K = DM; nN = 52; kind = EPI_IN; }
  else if (sp == 2) { A = (const bf16_t*)(ws + OFF_P); lda = P_LD; Bt = (const bf16_t*)(ws + OFF_WPOOL); ldb = 256; K = 256; nN = 4; kind = EPI_POOL; acs = 256; oc0 = 1024; }
  else if (sp == 3) { A = (const bf16_t*)(ws + OFF_Y); lda = Y_LD; Bt = (const bf16_t*)(ws + OFF_WBR); ldb = 1024; K = 1024; nN = 8; kind = EPI_BR; nsub = 3; asub = 1024; bsub = SZ_WBR1 / 2; }
  else if (sp == 4) { A = (const bf16_t*)(ws + OFF_PROJ); lda = M_LD; Bt = (const bf16_t*)(ws + OFF_WOUT); ldb = DM; K = DM; nN = 8; kind = EPI_RES; }
  else if (sp == 5) { A = (const bf16_t*)(ws + OFF_XB); lda = XB_LD; Bt = (const bf16_t*)(ws + OFF_WGU); ldb = DM; K = DM; nN = 44; kind = EPI_FFN1; ocs = 128; }
  else { A = (const bf16_t*)(ws + OFF_PROJ); lda = ACT_LD; Bt = (const bf16_t*)(ws + OFF_WDOWN); ldb = DFF; K = DFF; nN = 8; kind = EPI_RES; }
  gemm_phase(p, A, lda, Bt, ldb, K, nN, kind, nsub, asub, bsub, acs, oc0, ocs, hin, shm);
}

constexpr int LDS_BYTES = 8 * SBW_LDS + 16 > GEMM_LDS + 2048 + 16 ? 8 * SBW_LDS + 16 : GEMM_LDS + 2048 + 16;

__global__ void __launch_bounds__(512, 2) hybrid_megakernel(Params p_arg) {
  extern __shared__ __attribute__((aligned(16))) char shm[];
  KParams kp = (KParams)__builtin_amdgcn_kernarg_segment_ptr();
  const int phase_lo = kp->phase_lo, phase_hi = kp->phase_hi;
  volatile LAS unsigned* xst = (volatile LAS unsigned*)(LAS char*)(shm + LDS_BYTES - 16);
  const bool multi = phase_hi - phase_lo > 1;
  XcdBarrier xb{};
  if (multi) {
    if (threadIdx.x == 0) { xst[0] = 0u; xst[1] = 0u; }
    __syncthreads();
    xb = xcd_barrier_post((unsigned*)(kp->ws + OFF_BAR), xst);
  }
  for (int ph = phase_lo; ph < phase_hi; ++ph) {
    if (ph > phase_lo) { if (ph == 1) cg::this_grid().sync(); else xcd_barrier(xb, (unsigned*)(kp->ws + OFF_BAR)); }
    run_phase(kp, ph, shm);
  }
}

#ifndef SINGLE_LAUNCH
#define SINGLE_LAUNCH 1
#endif

extern "C" void kernel_launch(void* const* d_in, const int* in_sizes, int n_in, void* d_out, int out_size, void* d_ws, size_t ws_size, hipStream_t stream) {
  static int grid_blocks = 0;
  if (!grid_blocks) {
    hipFuncSetAttribute((const void*)hybrid_megakernel, hipFuncAttributeMaxDynamicSharedMemorySize, LDS_BYTES);
    int dev = 0, cus = 0, per_cu = 0;
    hipGetDevice(&dev);
    hipDeviceGetAttribute(&cus, hipDeviceAttributeMultiprocessorCount, dev);
    hipOccupancyMaxActiveBlocksPerMultiprocessor(&per_cu, hybrid_megakernel, 512, LDS_BYTES);
    if (per_cu < 1) per_cu = 1;
    grid_blocks = cus * per_cu;
    if (ws_size < WS_NEED) fprintf(stderr, "workspace too small: %zu < %zu\n", ws_size, (size_t)WS_NEED);
  }
  Params p{};
  p.x = (const float*)d_in[0]; p.norm_mix = (const float*)d_in[1]; p.norm_ffn = (const float*)d_in[2]; p.w_in = (const float*)d_in[3];
  p.w_pool = (const float*)d_in[4]; p.pool_scale = (const float*)d_in[5]; p.w_br_a = (const float*)d_in[6]; p.w_br_b = (const float*)d_in[7];
  p.w_br_c = (const float*)d_in[8]; p.w_out = (const float*)d_in[9]; p.w_gate = (const float*)d_in[10]; p.w_up = (const float*)d_in[11];
  p.w_down = (const float*)d_in[12]; p.rel_bias = (const float*)d_in[13]; p.norm_final = (const float*)d_in[14];
  p.out = (float*)d_out; p.ws = (char*)d_ws;
#if SINGLE_LAUNCH
  hipMemsetAsync((char*)d_ws + OFF_BAR, 0, 16384, stream);
  p.phase_lo = 0; p.phase_hi = NPHASE;
  void* args[] = {&p};
  hipError_t e = hipLaunchCooperativeKernel((const void*)hybrid_megakernel, dim3(grid_blocks), dim3(512), args, LDS_BYTES, stream);
  if (e != hipSuccess) fprintf(stderr, "cooperative launch failed: %s (grid %d)\n", hipGetErrorString(e), grid_blocks);
#else
  for (int ph = 0; ph < NPHASE; ++ph) {
    p.phase_lo = ph; p.phase_hi = ph + 1;
    hipLaunchKernelGGL(hybrid_megakernel, dim3(grid_blocks), dim3(512), LDS_BYTES, stream, p);
  }
#endif
}
```

```cpp
#include <hip/hip_runtime.h>
#include <hip/hip_cooperative_groups.h>
#include <cstdio>
namespace cg = cooperative_groups;
#ifndef REP_N
#define REP_N 1
#define REP_PH 0
#endif

#define LAS __attribute__((address_space(3)))
#define DI __device__ __forceinline__
typedef unsigned short bf16_t;
typedef short bf16x8 __attribute__((ext_vector_type(8)));
typedef short s16x4 __attribute__((ext_vector_type(4)));
typedef float f32x4 __attribute__((ext_vector_type(4)));
typedef float f32x16 __attribute__((ext_vector_type(16)));
typedef unsigned u32x4 __attribute__((ext_vector_type(4)));
typedef unsigned u32x2 __attribute__((ext_vector_type(2)));

constexpr int DM = 2048, NBATCH = 4, SEQ = 4096, MTOK = NBATCH * SEQ, INW = 13312, DFF = 5632;
constexpr int PAD = 128;
constexpr int PROJ_W = 7168, PROJ_LD = PROJ_W + PAD, GATE_LD = 6144 + PAD, Y_LD = 3072 + PAD, XB_LD = DM + PAD, M_LD = DM + PAD, ACT_LD = DFF + PAD, P_LD = 1024 + PAD;
constexpr float LOG2E = 1.4426950408889634f;

constexpr size_t SZ_WIN = (size_t)INW * DM * 2;
constexpr size_t SZ_WPOOL = (size_t)4 * 256 * 256 * 2;
constexpr size_t SZ_WBR1 = (size_t)DM * 1024 * 2;
constexpr size_t SZ_WOUT = (size_t)DM * DM * 2;
constexpr size_t SZ_WGU = (size_t)2 * DFF * DM * 2;
constexpr size_t SZ_WDOWN = (size_t)DM * DFF * 2;
constexpr size_t OFF_WIN = 0;
constexpr size_t OFF_WPOOL = OFF_WIN + SZ_WIN;
constexpr size_t OFF_WBR = OFF_WPOOL + SZ_WPOOL;
constexpr size_t OFF_WOUT = OFF_WBR + 3 * SZ_WBR1;
constexpr size_t OFF_WGU = OFF_WOUT + SZ_WOUT;
constexpr size_t OFF_WDOWN = OFF_WGU + SZ_WGU;
constexpr size_t OFF_PROJ = OFF_WDOWN + SZ_WDOWN;
constexpr size_t OFF_GATES = OFF_PROJ + (size_t)MTOK * PROJ_LD * 2;
constexpr size_t OFF_XB = OFF_GATES + (size_t)MTOK * GATE_LD * 2;
constexpr size_t OFF_Y = OFF_XB + (size_t)MTOK * XB_LD * 2;
constexpr size_t OFF_P = OFF_Y + (size_t)MTOK * Y_LD * 2;
constexpr size_t OFF_SSQ = OFF_P + (size_t)MTOK * P_LD * 2;
constexpr size_t OFF_KBAR = OFF_SSQ + (size_t)MTOK * 32 * 4;
constexpr size_t OFF_BAR = OFF_KBAR + (size_t)4 * 16 * 2 * 1024 * 4;
constexpr size_t WS_NEED = OFF_BAR + 16384;

struct Params {
  const float *x, *norm_mix, *norm_ffn, *w_in, *w_pool, *pool_scale, *w_br_a, *w_br_b, *w_br_c, *w_out, *w_gate, *w_up, *w_down, *rel_bias, *norm_final;
  float* out;
  char* ws;
  int phase_lo, phase_hi;
};
typedef const __attribute__((address_space(4))) Params* KParams;

DI const char* uni_ptr(const char* q) { const unsigned long long v = (unsigned long long)q; const unsigned lo = __builtin_amdgcn_readfirstlane((unsigned)v), hi = __builtin_amdgcn_readfirstlane((unsigned)(v >> 32)); return (const char*)(((unsigned long long)hi << 32) | lo); }
DI int opaque_tid() { int t = threadIdx.x; asm volatile("" : "+v"(t)); return t; }
DI unsigned pk_bf16(float lo, float hi) { unsigned r; asm("v_cvt_pk_bf16_f32 %0, %1, %2" : "=v"(r) : "v"(lo), "v"(hi)); return r; }
DI float bflo(unsigned v) { return __uint_as_float(v << 16); }
DI float bfhi(unsigned v) { return __uint_as_float(v & 0xffff0000u); }
DI float fexp2(float x) { return __builtin_amdgcn_exp2f(x); }
DI float flog2(float x) { return __builtin_amdgcn_logf(x); }
DI f32x16 mfma32(bf16x8 a, bf16x8 b, f32x16 c) { return __builtin_amdgcn_mfma_f32_32x32x16_bf16(a, b, c, 0, 0, 0); }


#define XB_TMO      128
#define XB_XCNT(j)  (256  + 64 * (j))
#define XB_XSUB(j)  (1280 + 64 * (j))
#define XB_XGEN(j)  (2304 + 64 * (j))
#define XB_TOP      3328
#define XB_TOPGEN   3392
#define XCD_BAR_WORDS 3456
#define XB_SPIN_CAP (1u << 18)
DI unsigned xb_ld(unsigned* q) { return __hip_atomic_load(q, __ATOMIC_RELAXED, __HIP_MEMORY_SCOPE_AGENT); }
DI unsigned xb_add(unsigned* q, unsigned v) { return __hip_atomic_fetch_add(q, v, __ATOMIC_RELAXED, __HIP_MEMORY_SCOPE_AGENT); }
DI unsigned xb_xcc_id() { return (unsigned)__builtin_amdgcn_s_getreg((3 << 11) | 20) & 0xFu; }
#define XB_SPIN(cond, bar) do { unsigned _sp = 0; while (cond) { __builtin_amdgcn_s_sleep(1); \
    if ((++_sp & 255u) == 0u) { if (xb_ld(&(bar)[XB_TMO])) break; if (_sp > XB_SPIN_CAP) { atomicAdd(&(bar)[XB_TMO], 1u); break; } } } } while (0)
struct XcdBarrier { unsigned* bar; unsigned x; volatile LAS unsigned* st; };
DI XcdBarrier xcd_barrier_post(unsigned* bar, volatile LAS unsigned* st) {
  XcdBarrier b; b.bar = bar; b.x = xb_xcc_id(); b.st = st;
  if (threadIdx.x == 0) (void)xb_add(&bar[XB_XCNT(b.x)], 1u);
  return b;
}
DI void xcd_barrier_complete(unsigned* bar, unsigned x, unsigned& nloc, unsigned& nx) {
  const unsigned G = gridDim.x * gridDim.y * gridDim.z;
  unsigned sum, cnt, mine, sp = 0u;
  for (;;) {
    sum = 0u; cnt = 0u; mine = 0u;
#pragma unroll
    for (unsigned j = 0; j < 16; ++j) { const unsigned c = xb_ld(&bar[XB_XCNT(j)]); sum += c; cnt += (c > 0u) ? 1u : 0u; mine = (j == x) ? c : mine; }
    if (sum == G) break;
    __builtin_amdgcn_s_sleep(1);
    if ((++sp & 255u) == 0u) { if (xb_ld(&bar[XB_TMO])) break; if (sp > XB_SPIN_CAP) { atomicAdd(&bar[XB_TMO], 1u); break; } }
  }
  nloc = mine > 0u ? mine : 1u; nx = cnt > 0u ? cnt : 1u;
}
DI void xcd_barrier(const XcdBarrier& b, unsigned* bar_in) {
  asm volatile("s_waitcnt vmcnt(0)" ::: "memory");
  __syncthreads();
  if (threadIdx.x == 0) {
    unsigned* bar = bar_in;
    __builtin_amdgcn_s_waitcnt(0);
    unsigned nloc = b.st[0], nx = b.st[1];
    if (nloc == 0u) { xcd_barrier_complete(bar, b.x, nloc, nx); b.st[0] = nloc; b.st[1] = nx; }
    const unsigned old = xb_add(&bar[XB_XSUB(b.x)], 1u);
    const unsigned gen = old / nloc;
    if (old + 1u == (gen + 1u) * nloc) {
      __builtin_amdgcn_fence(__ATOMIC_RELEASE, "agent");
      asm volatile("s_waitcnt vmcnt(0)" ::: "memory");
      const unsigned og = xb_add(&bar[XB_TOP], 1u);
      const unsigned tg = og / nx;
      if (og + 1u == (tg + 1u) * nx) xb_add(&bar[XB_TOPGEN], 1u);
      else XB_SPIN(xb_ld(&bar[XB_TOPGEN]) == tg, bar);
      __builtin_amdgcn_fence(__ATOMIC_ACQUIRE, "agent");
      xb_add(&bar[XB_XGEN(b.x)], 1u);
      asm volatile("s_waitcnt vmcnt(0)" ::: "memory");
    } else {
      XB_SPIN(xb_ld(&bar[XB_XGEN(b.x)]) == gen, bar);
      __builtin_amdgcn_fence(__ATOMIC_ACQUIRE, "agent");
      asm volatile("s_waitcnt vmcnt(0)" ::: "memory");
    }
  }
  __syncthreads();
}

struct CvtTile { const float* src; bf16_t* dst; const float* rs; const float* cs; int K, N, blk, bs, off, kt, nt; };
constexpr int CVT_T0 = 32 * 52, CVT_T1 = CVT_T0 + 16, CVT_T2 = CVT_T1 + 3 * 128, CVT_T3 = CVT_T2 + 256, CVT_T4 = CVT_T3 + 2 * 704, CVT_TOTAL = CVT_T4 + 704;
DI CvtTile cvt_tile(KParams p, int l, int t) {
  char* ws = p->ws; CvtTile c; c.rs = nullptr; c.cs = nullptr; c.bs = 0; c.off = 0;
  int tt;
  if (t < CVT_T0) { tt = t; c.src = p->w_in + (size_t)l * DM * INW; c.dst = (bf16_t*)(ws + OFF_WIN); c.K = DM; c.N = INW; c.blk = INW; c.rs = p->norm_mix + l * DM; }
  else if (t < CVT_T1) { const int g = (t - CVT_T0) >> 2; tt = (t - CVT_T0) & 3; c.src = p->w_pool + ((size_t)l * 4 + g) * 65536; c.dst = (bf16_t*)(ws + OFF_WPOOL) + g * 65536; c.K = 256; c.N = 256; c.blk = 256; c.cs = p->pool_scale + l * 1024 + g * 256; }
  else if (t < CVT_T2) { const int b = (t - CVT_T1) >> 7; tt = (t - CVT_T1) & 127; const float* wa = p->w_br_a; const float* wb = p->w_br_b; const float* wc3 = p->w_br_c; asm volatile("" : "+s"(wa), "+s"(wb), "+s"(wc3)); c.src = (b == 0 ? wa : b == 1 ? wb : wc3) + (size_t)l * 1024 * DM; c.dst = (bf16_t*)(ws + OFF_WBR + b * SZ_WBR1); c.K = 1024; c.N = DM; c.blk = DM; }
  else if (t < CVT_T3) { tt = t - CVT_T2; c.src = p->w_out + (size_t)l * DM * DM; c.dst = (bf16_t*)(ws + OFF_WOUT); c.K = DM; c.N = DM; c.blk = DM; }
  else if (t < CVT_T4) { const int u = (t - CVT_T3) >= 704; tt = (t - CVT_T3) - u * 704; const float* wg = p->w_gate; const float* wu = p->w_up; asm volatile("" : "+s"(wg), "+s"(wu)); c.src = (u ? wu : wg) + (size_t)l * DM * DFF; c.dst = (bf16_t*)(ws + OFF_WGU); c.K = DM; c.N = DFF; c.blk = 128; c.bs = 256; c.off = u * 128; c.rs = p->norm_ffn + l * DM; }
  else { tt = t - CVT_T4; c.src = p->w_down + (size_t)l * DFF * DM; c.dst = (bf16_t*)(ws + OFF_WDOWN); c.K = DFF; c.N = DM; c.blk = DM; }
  const int ntn = c.N >> 8; c.kt = tt / ntn; c.nt = tt - c.kt * ntn;
  return c;
}

DI void convert_layer(KParams p, int l, char* shm) {
  float* tile = (float*)shm;
  const int tid = opaque_tid(), lane = tid & 63, w = tid >> 6;
  f32x4 v[8];
#define CVT_LOAD(tt) do { const CvtTile _c = cvt_tile(p, l, (tt)); \
    _Pragma("unroll") for (int i = 0; i < 8; ++i) { const int idx = tid + 512 * i, k = idx >> 6, n4 = idx & 63; v[i] = __builtin_nontemporal_load((const f32x4*)(_c.src + (size_t)(_c.kt * 64 + k) * _c.N + _c.nt * 256 + 4 * n4)); } } while (0)
  if ((int)blockIdx.x < CVT_TOTAL) CVT_LOAD(blockIdx.x);
  for (int t = blockIdx.x; t < CVT_TOTAL; t += gridDim.x) {
    const CvtTile c = cvt_tile(p, l, t);
    const int k0 = c.kt * 64, n0 = c.nt * 256;
    __syncthreads();
#pragma unroll
    for (int i = 0; i < 8; ++i) { const int idx = tid + 512 * i, k = idx >> 6, n4 = idx & 63; *(f32x4*)(tile + k * 256 + 4 * (n4 ^ ((k >> 3) & 7))) = v[i]; }
    __syncthreads();
    if (t + (int)gridDim.x < CVT_TOTAL) CVT_LOAD(t + gridDim.x);
    const int kc = lane >> 3;
    f32x4 g0 = {1.f, 1.f, 1.f, 1.f}, g1 = g0;
    if (c.rs) { g0 = *(const f32x4*)(c.rs + k0 + kc * 8); g1 = *(const f32x4*)(c.rs + k0 + kc * 8 + 4); }
#pragma unroll
    for (int pass = 0; pass < 4; ++pass) {
      const int n = 32 * w + 8 * pass + (lane & 7);
      float f[8];
#pragma unroll
      for (int j = 0; j < 8; ++j) f[j] = tile[(kc * 8 + j) * 256 + 4 * ((n >> 2) ^ kc) + (n & 3)];
      const int ng = n0 + n;
      const float cc = c.cs ? c.cs[ng] : 1.f;
      u32x4 o;
      o[0] = pk_bf16(f[0] * g0[0] * cc, f[1] * g0[1] * cc); o[1] = pk_bf16(f[2] * g0[2] * cc, f[3] * g0[3] * cc);
      o[2] = pk_bf16(f[4] * g1[0] * cc, f[5] * g1[1] * cc); o[3] = pk_bf16(f[6] * g1[2] * cc, f[7] * g1[3] * cc);
      const int q = ng / c.blk, dr0 = q * c.bs + c.off + (ng - q * c.blk);
      const int c32 = dr0 & 31, drow = (dr0 & ~31) + 16 * ((c32 >> 2) & 1) + 4 * (c32 >> 3) + (c32 & 3);
      *(u32x4*)(c.dst + (size_t)drow * c.K + k0 + kc * 8) = o;
    }
  }
#undef CVT_LOAD
}

DI void x_prep(KParams p) {
  const int tid = opaque_tid(), lane = tid & 63, w = tid >> 6;
  bf16_t* xb = (bf16_t*)(p->ws + OFF_XB); float* ssq = (float*)(p->ws + OFF_SSQ);
  const float* x = p->x;
  for (int row = blockIdx.x * 8 + w; row < MTOK; row += gridDim.x * 16) {
    const int row2 = row + gridDim.x * 8;
    const bool has2 = row2 < MTOK;
    f32x4 va[8], vb[8];
#pragma unroll
    for (int i = 0; i < 8; ++i) { const int c = (i * 64 + lane) * 4; va[i] = __builtin_nontemporal_load((const f32x4*)(x + (size_t)row * DM + c)); vb[i] = has2 ? __builtin_nontemporal_load((const f32x4*)(x + (size_t)row2 * DM + c)) : (f32x4){0.f, 0.f, 0.f, 0.f}; }
    float s0 = 0.f, s1 = 0.f;
#pragma unroll
    for (int i = 0; i < 8; ++i) {
      const int c = (i * 64 + lane) * 4;
      s0 += va[i][0] * va[i][0] + va[i][1] * va[i][1] + va[i][2] * va[i][2] + va[i][3] * va[i][3];
      s1 += vb[i][0] * vb[i][0] + vb[i][1] * vb[i][1] + vb[i][2] * vb[i][2] + vb[i][3] * vb[i][3];
      u32x2 o; o[0] = pk_bf16(va[i][0], va[i][1]); o[1] = pk_bf16(va[i][2], va[i][3]);
      *(u32x2*)(xb + (size_t)row * XB_LD + c) = o;
      if (has2) { u32x2 o2; o2[0] = pk_bf16(vb[i][0], vb[i][1]); o2[1] = pk_bf16(vb[i][2], vb[i][3]); *(u32x2*)(xb + (size_t)row2 * XB_LD + c) = o2; }
    }
    s0 += __shfl_xor(s0, 32); s1 += __shfl_xor(s1, 32);
    if (lane < 32) { ssq[(size_t)row * 32 + lane] = s0; if (has2) ssq[(size_t)row2 * 32 + lane] = s1; }
  }
}

DI void final_norm(KParams p) {
  const int tid = opaque_tid(), lane = tid & 63, w = tid >> 6;
  const float* ssq = (const float*)(p->ws + OFF_SSQ);
  const bf16_t* xb = (const bf16_t*)(p->ws + OFF_XB);
  float* out = p->out;
  f32x4 g[4][2];
#pragma unroll
  for (int i = 0; i < 4; ++i) { g[i][0] = *(const f32x4*)(p->norm_final + (i * 64 + lane) * 8); g[i][1] = *(const f32x4*)(p->norm_final + (i * 64 + lane) * 8 + 4); }
  for (int row = blockIdx.x * 8 + w; row < MTOK; row += gridDim.x * 16) {
    const int row2 = row + gridDim.x * 8;
    const bool has2 = row2 < MTOK;
    float s0 = (lane < 32) ? ssq[(size_t)row * 32 + lane] : 0.f, s1 = (lane < 32 && has2) ? ssq[(size_t)row2 * 32 + lane] : 0.f;
    u32x4 va[4], vb[4];
#pragma unroll
    for (int i = 0; i < 4; ++i) { const int c = (i * 64 + lane) * 8; va[i] = *(const u32x4*)(xb + (size_t)row * XB_LD + c); vb[i] = has2 ? *(const u32x4*)(xb + (size_t)row2 * XB_LD + c) : (u32x4){0u, 0u, 0u, 0u}; }
#pragma unroll
    for (int o = 32; o >= 1; o >>= 1) { s0 += __shfl_xor(s0, o); s1 += __shfl_xor(s1, o); }
    const float r0 = rsqrtf(s0 * (1.f / DM) + 1e-6f), r1 = rsqrtf(s1 * (1.f / DM) + 1e-6f);
#pragma unroll
    for (int i = 0; i < 4; ++i) {
      const int c = (i * 64 + lane) * 8;
      f32x4 a, b;
      a[0] = bflo(va[i][0]) * r0 * g[i][0][0]; a[1] = bfhi(va[i][0]) * r0 * g[i][0][1]; a[2] = bflo(va[i][1]) * r0 * g[i][0][2]; a[3] = bfhi(va[i][1]) * r0 * g[i][0][3];
      b[0] = bflo(va[i][2]) * r0 * g[i][1][0]; b[1] = bfhi(va[i][2]) * r0 * g[i][1][1]; b[2] = bflo(va[i][3]) * r0 * g[i][1][2]; b[3] = bfhi(va[i][3]) * r0 * g[i][1][3];
      *(f32x4*)(out + (size_t)row * DM + c) = a; *(f32x4*)(out + (size_t)row * DM + c + 4) = b;
      if (has2) {
        a[0] = bflo(vb[i][0]) * r1 * g[i][0][0]; a[1] = bfhi(vb[i][0]) * r1 * g[i][0][1]; a[2] = bflo(vb[i][1]) * r1 * g[i][0][2]; a[3] = bfhi(vb[i][1]) * r1 * g[i][0][3];
        b[0] = bflo(vb[i][2]) * r1 * g[i][1][0]; b[1] = bfhi(vb[i][2]) * r1 * g[i][1][1]; b[2] = bflo(vb[i][3]) * r1 * g[i][1][2]; b[3] = bfhi(vb[i][3]) * r1 * g[i][1][3];
        *(f32x4*)(out + (size_t)row2 * DM + c) = a; *(f32x4*)(out + (size_t)row2 * DM + c + 4) = b;
      }
    }
  }
}

DI void pool_tile(KParams p, int brow, int g) {
  const bf16_t* proj = (const bf16_t*)(p->ws + OFF_PROJ);
  bf16_t* P = (bf16_t*)(p->ws + OFF_P);
  const int tid = opaque_tid();
  const int win = 2 << g;
  for (int it = 0; it < 16; it += 2) {
    const int idx0 = it * 512 + tid, idx1 = idx0 + 512, c = g * 256 + (tid & 31) * 8;
    const int tok0 = brow + (idx0 >> 5), tok1 = brow + (idx1 >> 5);
    const int cnt0 = min(win, (tok0 & (SEQ - 1)) + 1), cnt1 = min(win, (tok1 & (SEQ - 1)) + 1);
    const bf16_t* up0 = proj + (size_t)tok0 * PROJ_LD + 3072 + c;
    const bf16_t* up1 = proj + (size_t)tok1 * PROJ_LD + 3072 + c;
    u32x4 ua[16], ub[16];
#pragma unroll
    for (int j = 0; j < 16; ++j) {
      ua[j] = (j < cnt0) ? *(const u32x4*)(up0 - (size_t)j * PROJ_LD) : (u32x4){0u, 0u, 0u, 0u};
      ub[j] = (j < cnt1) ? *(const u32x4*)(up1 - (size_t)j * PROJ_LD) : (u32x4){0u, 0u, 0u, 0u};
    }
    float a0[8] = {0.f, 0.f, 0.f, 0.f, 0.f, 0.f, 0.f, 0.f}, a1[8] = {0.f, 0.f, 0.f, 0.f, 0.f, 0.f, 0.f, 0.f};
#pragma unroll
    for (int j = 0; j < 16; ++j) {
#pragma unroll
      for (int e = 0; e < 4; ++e) { a0[2 * e] += bflo(ua[j][e]); a0[2 * e + 1] += bfhi(ua[j][e]); a1[2 * e] += bflo(ub[j][e]); a1[2 * e + 1] += bfhi(ub[j][e]); }
    }
    const float i0 = 1.f / (float)cnt0, i1 = 1.f / (float)cnt1;
    u32x4 o0, o1;
#pragma unroll
    for (int e = 0; e < 4; ++e) {
      o0[e] = pk_bf16(a0[2 * e] * i0 - bflo(ua[0][e]), a0[2 * e + 1] * i0 - bfhi(ua[0][e]));
      o1[e] = pk_bf16(a1[2 * e] * i1 - bflo(ub[0][e]), a1[2 * e + 1] * i1 - bfhi(ub[0][e]));
    }
    *(u32x4*)(P + (size_t)tok0 * P_LD + c) = o0;
    *(u32x4*)(P + (size_t)tok1 * P_LD + c) = o1;
  }
}

constexpr int BK = 64, HALF = 128, HT = HALF * BK;
constexpr int GEMM_LDS = 8 * HT * 2;
constexpr int RS_OFF = GEMM_LDS;
enum { EPI_IN = 0, EPI_POOL = 1, EPI_BR = 2, EPI_RES = 3, EPI_FFN1 = 4 };

DI int lds_byte(int r, int c) { const int st = (r >> 4) * 2 + (c >> 5), rr = r & 15, cc = c & 31, ob = rr * 64 + cc * 2; return st * 1024 + (ob ^ (((ob >> 9) & 1) << 5)); }
DI void stage_rc(int b, int& R, int& C) { const int st = b / 1024, sb = b % 1024, swz = sb ^ (((sb >> 9) & 1) << 5); R = (st >> 1) * 16 + swz / 64; C = (st & 1) * 32 + (swz % 64) / 2; }

DI bool tile_order(int L, int nM, int nN, int& pm, int& pn) {
  const int nwg = nM * nN; if (L >= nwg) return false;
  int wgid = L; { const int q = nwg / 8, r = nwg % 8, xcd = wgid % 8, off = wgid / 8; wgid = (xcd < r ? xcd * (q + 1) : r * (q + 1) + (xcd - r) * q) + off; }
  const int nig = 8 * nN, gid = wgid / nig, fm = gid * 8, gsz = (nM - fm) < 8 ? (nM - fm) : 8;
  pm = fm + ((wgid % nig) % gsz); pn = (wgid % nig) / gsz; return true;
}

DI void gemm_phase(KParams p, const bf16_t* __restrict__ A, int lda, const bf16_t* __restrict__ Bt, int ldb, int K, int nN, int kind,
                   int nsub, size_t asub, size_t bsub, int acs, int oc0, int ocs, const float* hin, char* shmc) {
  LAS unsigned char* lds = (LAS unsigned char*)shmc;
  const int tid = opaque_tid();
  const int wid = __builtin_amdgcn_readfirstlane(tid >> 6), lane = tid & 63, wr = wid >> 2, wc = wid & 3, fr = lane & 15, fq = lane >> 4;
  unsigned voffA[2], voffB[2];
#pragma unroll
  for (int i = 0; i < 2; ++i) { int R, C; stage_rc(tid * 16 + i * 8192, R, C); voffA[i] = (unsigned)(R * lda + C) * 2u; voffB[i] = (unsigned)(R * ldb + C) * 2u; }
  const unsigned ldsw = (unsigned)wid * 1024u;
  const int aoff = lds_byte(wr * 64 + fr, fq * 8), boff = lds_byte(wc * 32 + fr, fq * 8);
  const size_t hA = (size_t)HALF * lda * 2, hB = (size_t)HALF * ldb * 2;
#define SA(b, h) (((b) * 2 + (h)) * (HT * 2))
#define SB(b, h) ((4 + (b) * 2 + (h)) * (HT * 2))
#define STAGE(bufoff, gbase, voff) do { const char* _gb = uni_ptr(gbase); _Pragma("unroll") for (int _i = 0; _i < 2; ++_i) { unsigned _vo = (voff)[_i]; asm volatile("" : "+v"(_vo)); \
    __builtin_amdgcn_global_load_lds((const unsigned*)(_gb + _vo), (LAS unsigned*)(lds + (bufoff) + ldsw + _i * 8192), 16, 0, 0); } } while (0)
#define STA(P, hf, kt) STAGE(P, cA + (hf) * hA + (size_t)(kt) * (BK * 2), voffA)
#define STB(P, hf, kt) STAGE(P, cB + (hf) * hB + (size_t)(kt) * (BK * 2), voffB)
#define ISSUE_PROLOGUE() do { STB(SB(0, 0), 0, 0); STA(SA(0, 0), 0, 0); STB(SB(0, 1), 1, 0); STA(SA(0, 1), 1, 0); \
    STB(SB(1, 0), 0, 1); STA(SA(1, 0), 0, 1); STB(SB(1, 1), 1, 1); } while (0)
#define LDA(dst, b, h) do { _Pragma("unroll") for (int m = 0; m < 4; ++m) _Pragma("unroll") for (int k = 0; k < 2; ++k) dst[m][k] = *(const LAS bf16x8*)(lds + SA(b, h) + aoff + m * 2048 + k * 1024); } while (0)
#define LDB(dst, b, h) do { _Pragma("unroll") for (int n = 0; n < 2; ++n) _Pragma("unroll") for (int k = 0; k < 2; ++k) dst[n][k] = *(const LAS bf16x8*)(lds + SB(b, h) + boff + n * 2048 + k * 1024); } while (0)
#define MMA(ai, bj, Af, Bf) do { __builtin_amdgcn_s_setprio(1); \
    _Pragma("unroll") for (int m = 0; m < 4; ++m) _Pragma("unroll") for (int n = 0; n < 2; ++n) _Pragma("unroll") for (int k = 0; k < 2; ++k) \
      acc[ai][bj][m][n] = __builtin_amdgcn_mfma_f32_16x16x32_bf16(Bf[n][k], Af[m][k], acc[ai][bj][m][n], 0, 0, 0); \
    __builtin_amdgcn_s_setprio(0); } while (0)
#define WAIT_V(n) asm volatile("s_waitcnt vmcnt(" #n ")" ::: "memory")
#define WAIT_L(n) asm volatile("s_waitcnt lgkmcnt(" #n ")" ::: "memory")
#define BAR __builtin_amdgcn_s_barrier()
#define SCHED __builtin_amdgcn_sched_barrier(0)

  int pm, pn, sub = 0, rnd = 0, rs_brow = -1;
  if (!tile_order(blockIdx.x, 64, nN, pm, pn)) return;
  const char* cA = (const char*)(A + pn * acs) + (size_t)pm * 256 * lda * 2;
  const char* cB = (const char*)Bt + (size_t)pn * 256 * ldb * 2;
  if (kind == EPI_POOL) {
    int qm, qn;
    for (int r2 = 0; tile_order(r2 * gridDim.x + blockIdx.x, 64, nN, qm, qn); ++r2) pool_tile(p, qm * 256, qn);
    asm volatile("s_waitcnt vmcnt(0)" ::: "memory");
  }
  __syncthreads();
  ISSUE_PROLOGUE();
  const int nt = K / BK;
  bool have = true;
  while (have) {
    const int brow = pm * 256, ocol = oc0 + pn * ocs, aux = sub;
    float* rsl = (float*)(shmc + RS_OFF);
    if ((kind == EPI_IN || kind == EPI_FFN1) && brow != rs_brow) {
      rs_brow = brow;
      __syncthreads();
      if (tid < 256) {
        const float* sp = (const float*)(p->ws + OFF_SSQ) + (size_t)(brow + tid) * 32;
        float s = 0.f;
#pragma unroll
        for (int i = 0; i < 8; ++i) { const f32x4 v = *(const f32x4*)(sp + 4 * i); s += (v[0] + v[1]) + (v[2] + v[3]); }
        rsl[tid] = rsqrtf(s * (1.f / DM) + 1e-6f);
      }
    }
    f32x4 acc[2][2][4][2];
#pragma unroll
    for (int a = 0; a < 2; ++a)
#pragma unroll
      for (int b = 0; b < 2; ++b)
#pragma unroll
        for (int m = 0; m < 4; ++m)
#pragma unroll
          for (int n = 0; n < 2; ++n) acc[a][b][m][n] = (f32x4){0.f, 0.f, 0.f, 0.f};
    bf16x8 At[4][2], B0[2][2], B1[2][2];
    if (wr == 1) BAR;
    WAIT_V(10); BAR;
    WAIT_V(6); BAR;
    for (int t = 0; t < nt - 2; t += 2) {
      LDB(B0, 0, 0); SCHED; LDA(At, 0, 0); STA(SA(1, 1), 1, t + 1);
      WAIT_L(8); BAR; WAIT_L(0); MMA(0, 0, At, B0); BAR; SCHED;
      LDB(B1, 0, 1); STB(SB(0, 0), 0, t + 2);
      BAR; WAIT_L(0); MMA(0, 1, At, B1); BAR;
      LDA(At, 0, 1); STA(SA(0, 0), 0, t + 2);
      BAR; WAIT_L(0); MMA(1, 0, At, B0); BAR; SCHED;
      STB(SB(0, 1), 1, t + 2);
      WAIT_V(6); BAR; MMA(1, 1, At, B1); BAR;
      LDB(B0, 1, 0); SCHED; LDA(At, 1, 0); STA(SA(0, 1), 1, t + 2);
      WAIT_L(8); BAR; WAIT_L(0); MMA(0, 0, At, B0); BAR; SCHED;
      LDB(B1, 1, 1); STB(SB(1, 0), 0, t + 3);
      BAR; WAIT_L(0); MMA(0, 1, At, B1); BAR;
      LDA(At, 1, 1); STA(SA(1, 0), 0, t + 3);
      BAR; WAIT_L(0); MMA(1, 0, At, B0); BAR; SCHED;
      STB(SB(1, 1), 1, t + 3);
      WAIT_V(6); BAR; MMA(1, 1, At, B1); BAR;
    }
    { LDB(B0, 0, 0); LDA(At, 0, 0); STA(SA(1, 1), 1, nt - 1);
      BAR; WAIT_L(0); MMA(0, 0, At, B0); BAR;
      LDB(B1, 0, 1); BAR; WAIT_L(0); MMA(0, 1, At, B1); BAR;
      LDA(At, 0, 1); WAIT_V(4); BAR; WAIT_L(0); MMA(1, 0, At, B0); MMA(1, 1, At, B1); BAR; }
    { LDB(B0, 1, 0); LDA(At, 1, 0); WAIT_V(2); BAR; WAIT_L(0); MMA(0, 0, At, B0); BAR;
      LDB(B1, 1, 1); WAIT_V(0); BAR; WAIT_L(0); MMA(0, 1, At, B1); BAR;
      LDA(At, 1, 1); BAR; WAIT_L(0); MMA(1, 0, At, B0); MMA(1, 1, At, B1); BAR; }
    if (wr == 0) BAR;
    {
      int pm2 = pm, pn2 = pn, sub2 = sub + 1;
      if (sub2 == nsub) { sub2 = 0; ++rnd; have = tile_order(rnd * gridDim.x + blockIdx.x, 64, nN, pm2, pn2); }
      if (have) {
        cA = (const char*)(A + sub2 * asub + pn2 * acs) + (size_t)pm2 * 256 * lda * 2;
        cB = (const char*)(Bt + sub2 * bsub) + (size_t)pn2 * 256 * ldb * 2;
        ISSUE_PROLOGUE();
      }
      pm = pm2; pn = pn2; sub = sub2;
    }
    char* ws = p->ws;
    int cl = wc * 32 + 8 * fq; asm volatile("" : "+v"(cl));
    int fr_e = fr; asm volatile("" : "+v"(fr_e));
    if (kind == EPI_IN) {
      const bool isgate = ocol >= PROJ_W;
      bf16_t* obase = isgate ? (bf16_t*)(ws + OFF_GATES) + (ocol - PROJ_W) : (bf16_t*)(ws + OFF_PROJ) + ocol;
      const int old = isgate ? GATE_LD : PROJ_LD;
#pragma unroll
      for (int ai = 0; ai < 2; ++ai)
#pragma unroll
        for (int m = 0; m < 4; ++m) {
          const int rl = ai * HALF + wr * 64 + m * 16 + fr_e;
          const float rs = rsl[rl];
          bf16_t* rowp = obase + (size_t)(brow + rl) * old + cl;
#pragma unroll
          for (int bj = 0; bj < 2; ++bj) {
            f32x4 v0 = acc[ai][bj][m][0] * rs, v1 = acc[ai][bj][m][1] * rs;
            if (isgate) {
#pragma unroll
              for (int j = 0; j < 4; ++j) { v0[j] = __builtin_amdgcn_rcpf(1.f + fexp2(-LOG2E * v0[j])); v1[j] = __builtin_amdgcn_rcpf(1.f + fexp2(-LOG2E * v1[j])); }
            }
            u32x4 o; o[0] = pk_bf16(v0[0], v0[1]); o[1] = pk_bf16(v0[2], v0[3]); o[2] = pk_bf16(v1[0], v1[1]); o[3] = pk_bf16(v1[2], v1[3]);
            *(u32x4*)(rowp + bj * HALF) = o;
          }
        }
      if (ocol >= 1024 && ocol < 2048) {
        float* kb2 = (float*)(ws + OFF_KBAR) + ((size_t)(brow >> 8) * 2 + wr) * 1024 + (ocol - 1024) + cl;
#pragma unroll
        for (int bj = 0; bj < 2; ++bj)
#pragma unroll
          for (int n = 0; n < 2; ++n) {
            f32x4 s = {0.f, 0.f, 0.f, 0.f};
#pragma unroll
            for (int ai = 0; ai < 2; ++ai)
#pragma unroll
              for (int m = 0; m < 4; ++m) s += acc[ai][bj][m][n] * rsl[ai * HALF + wr * 64 + m * 16 + fr_e];
#pragma unroll
            for (int j = 0; j < 4; ++j) { float t = s[j]; t += __shfl_xor(t, 1); t += __shfl_xor(t, 2); t += __shfl_xor(t, 4); t += __shfl_xor(t, 8); s[j] = t; }
            if (fr_e == 0) *(f32x4*)(kb2 + bj * HALF + 4 * n) = s;
          }
      }
    } else if (kind == EPI_POOL) {
      bf16_t* obase = (bf16_t*)(ws + OFF_Y) + ocol;
#pragma unroll
      for (int ai = 0; ai < 2; ++ai)
#pragma unroll
        for (int m = 0; m < 4; ++m) {
          const int rl = ai * HALF + wr * 64 + m * 16 + fr_e;
          bf16_t* rowp = obase + (size_t)(brow + rl) * Y_LD + cl;
#pragma unroll
          for (int bj = 0; bj < 2; ++bj) {
            const f32x4 v0 = acc[ai][bj][m][0], v1 = acc[ai][bj][m][1];
            u32x4 o; o[0] = pk_bf16(v0[0], v0[1]); o[1] = pk_bf16(v0[2], v0[3]); o[2] = pk_bf16(v1[0], v1[1]); o[3] = pk_bf16(v1[2], v1[3]);
            *(u32x4*)(rowp + bj * HALF) = o;
          }
        }
    } else if (kind == EPI_BR) {
      const bf16_t* gbase = (const bf16_t*)(ws + OFF_GATES) + aux * DM + ocol;
      bf16_t* mbase = (bf16_t*)(ws + OFF_PROJ) + ocol;
#pragma unroll
      for (int ai = 0; ai < 2; ++ai) {
        u32x4 gg[4][2], mm[4][2];
#pragma unroll
        for (int m = 0; m < 4; ++m) {
          const int rl = ai * HALF + wr * 64 + m * 16 + fr_e;
          const bf16_t* grow = gbase + (size_t)(brow + rl) * GATE_LD + cl;
          const bf16_t* mrow = mbase + (size_t)(brow + rl) * M_LD + cl;
#pragma unroll
          for (int bj = 0; bj < 2; ++bj) {
            gg[m][bj] = *(const u32x4*)(grow + bj * HALF);
            mm[m][bj] = (aux != 0) ? *(const u32x4*)(mrow + bj * HALF) : (u32x4){0u, 0u, 0u, 0u};
          }
        }
#pragma unroll
        for (int m = 0; m < 4; ++m) {
          const int rl = ai * HALF + wr * 64 + m * 16 + fr_e;
          bf16_t* mrow = mbase + (size_t)(brow + rl) * M_LD + cl;
#pragma unroll
          for (int bj = 0; bj < 2; ++bj) {
            const u32x4 g = gg[m][bj], mo = mm[m][bj];
            f32x4 v0 = acc[ai][bj][m][0], v1 = acc[ai][bj][m][1];
            v0[0] = v0[0] * bflo(g[0]) + bflo(mo[0]); v0[1] = v0[1] * bfhi(g[0]) + bfhi(mo[0]); v0[2] = v0[2] * bflo(g[1]) + bflo(mo[1]); v0[3] = v0[3] * bfhi(g[1]) + bfhi(mo[1]);
            v1[0] = v1[0] * bflo(g[2]) + bflo(mo[2]); v1[1] = v1[1] * bfhi(g[2]) + bfhi(mo[2]); v1[2] = v1[2] * bflo(g[3]) + bflo(mo[3]); v1[3] = v1[3] * bfhi(g[3]) + bfhi(mo[3]);
            u32x4 o; o[0] = pk_bf16(v0[0], v0[1]); o[1] = pk_bf16(v0[2], v0[3]); o[2] = pk_bf16(v1[0], v1[1]); o[3] = pk_bf16(v1[2], v1[3]);
            *(u32x4*)(mrow + bj * HALF) = o;
          }
        }
      }
    } else if (kind == EPI_RES) {
      bf16_t* xb = (bf16_t*)(ws + OFF_XB) + ocol;
      float* ssq = (float*)(ws + OFF_SSQ);
      const int pslot = (ocol >> 8) * 4 + wc;
#pragma unroll
      for (int ai = 0; ai < 2; ++ai) {
        u32x4 hh[4][2];
#pragma unroll
        for (int m = 0; m < 4; ++m) {
          const int rl = ai * HALF + wr * 64 + m * 16 + fr_e;
          const bf16_t* xr = xb + (size_t)(brow + rl) * XB_LD + cl;
#pragma unroll
          for (int bj = 0; bj < 2; ++bj) hh[m][bj] = *(const u32x4*)(xr + bj * HALF);
        }
#pragma unroll
        for (int m = 0; m < 4; ++m) {
          const int rl = ai * HALF + wr * 64 + m * 16 + fr_e;
          bf16_t* xr = xb + (size_t)(brow + rl) * XB_LD + cl;
          float s = 0.f;
#pragma unroll
          for (int bj = 0; bj < 2; ++bj) {
            const u32x4 h = hh[m][bj];
            f32x4 v0 = acc[ai][bj][m][0], v1 = acc[ai][bj][m][1];
            v0[0] += bflo(h[0]); v0[1] += bfhi(h[0]); v0[2] += bflo(h[1]); v0[3] += bfhi(h[1]);
            v1[0] += bflo(h[2]); v1[1] += bfhi(h[2]); v1[2] += bflo(h[3]); v1[3] += bfhi(h[3]);
            s += v0[0] * v0[0] + v0[1] * v0[1] + v0[2] * v0[2] + v0[3] * v0[3] + v1[0] * v1[0] + v1[1] * v1[1] + v1[2] * v1[2] + v1[3] * v1[3];
            u32x4 o; o[0] = pk_bf16(v0[0], v0[1]); o[1] = pk_bf16(v0[2], v0[3]); o[2] = pk_bf16(v1[0], v1[1]); o[3] = pk_bf16(v1[2], v1[3]);
            *(u32x4*)(xr + bj * HALF) = o;
          }
          s += __shfl_xor(s, 16); s += __shfl_xor(s, 32);
          if (fq == 0) ssq[(size_t)(brow + rl) * 32 + pslot] = s;
        }
      }
    } else {
      bf16_t* abase = (bf16_t*)(ws + OFF_PROJ) + ocol;
#pragma unroll
      for (int ai = 0; ai < 2; ++ai)
#pragma unroll
        for (int m = 0; m < 4; ++m) {
          const int rl = ai * HALF + wr * 64 + m * 16 + fr_e;
          const float rs = rsl[rl];
          bf16_t* rowp = abase + (size_t)(brow + rl) * ACT_LD + cl;
          f32x4 v[2];
#pragma unroll
          for (int n = 0; n < 2; ++n) {
            const f32x4 g = acc[ai][0][m][n] * rs, u = acc[ai][1][m][n] * rs;
#pragma unroll
            for (int j = 0; j < 4; ++j) v[n][j] = g[j] * __builtin_amdgcn_rcpf(1.f + fexp2(-LOG2E * g[j])) * u[j];
          }
          u32x4 o; o[0] = pk_bf16(v[0][0], v[0][1]); o[1] = pk_bf16(v[0][2], v[0][3]); o[2] = pk_bf16(v[1][0], v[1][1]); o[3] = pk_bf16(v[1][2], v[1][3]);
          *(u32x4*)rowp = o;
        }
    }
  }
}

DI void branch_phase(KParams p, char* shmc) {
  LAS unsigned char* lds = (LAS unsigned char*)shmc;
  const int tid = opaque_tid();
  const int wid = __builtin_amdgcn_readfirstlane(tid >> 6), lane = tid & 63, wr = wid >> 2, wc = wid & 3, fr = lane & 15, fq = lane >> 4;
  const int lda = Y_LD, ldb = 1024;
  unsigned voffA[2], voffB[2];
#pragma unroll
  for (int i = 0; i < 2; ++i) { int R, C; stage_rc(tid * 16 + i * 8192, R, C); voffA[i] = (unsigned)(R * lda + C) * 2u; voffB[i] = (unsigned)(R * ldb + C) * 2u; }
  const unsigned ldsw = (unsigned)wid * 1024u;
  const int aoff = lds_byte(wr * 64 + fr, fq * 8), boff = lds_byte(wc * 32 + fr, fq * 8);
  const size_t hA = (size_t)HALF * lda * 2, hB = (size_t)HALF * ldb * 2;
  char* ws = p->ws;
  const bf16_t* Y = (const bf16_t*)(ws + OFF_Y); const bf16_t* W = (const bf16_t*)(ws + OFF_WBR);
  int pm, pn, rnd = 0;
  if (!tile_order(blockIdx.x, 64, 8, pm, pn)) return;
  const char* cA = (const char*)Y + (size_t)pm * 256 * lda * 2;
  const char* cB = (const char*)W + (size_t)pn * 256 * ldb * 2;
  __syncthreads();
  ISSUE_PROLOGUE();
  const int nt = 16;
  bool have = true;
  while (have) {
    const int brow = pm * 256, ocol = pn * 256;
    int pm2 = pm, pn2 = pn;
    f32x4 acc[2][2][4][2];
#pragma unroll
    for (int a = 0; a < 2; ++a)
#pragma unroll
      for (int b = 0; b < 2; ++b)
#pragma unroll
        for (int m = 0; m < 4; ++m)
#pragma unroll
          for (int n = 0; n < 2; ++n) acc[a][b][m][n] = (f32x4){0.f, 0.f, 0.f, 0.f};
#pragma unroll 1
    for (int br = 0; br < 3; ++br) {
      bf16x8 At[4][2], B0[2][2], B1[2][2];
      if (wr == 1) BAR;
      WAIT_V(10); BAR;
      WAIT_V(6); BAR;
      for (int t = 0; t < nt - 2; t += 2) {
        LDB(B0, 0, 0); SCHED; LDA(At, 0, 0); STA(SA(1, 1), 1, t + 1);
        WAIT_L(8); BAR; WAIT_L(0); MMA(0, 0, At, B0); BAR; SCHED;
        LDB(B1, 0, 1); STB(SB(0, 0), 0, t + 2);
        BAR; WAIT_L(0); MMA(0, 1, At, B1); BAR;
        LDA(At, 0, 1); STA(SA(0, 0), 0, t + 2);
        BAR; WAIT_L(0); MMA(1, 0, At, B0); BAR; SCHED;
        STB(SB(0, 1), 1, t + 2);
        WAIT_V(6); BAR; MMA(1, 1, At, B1); BAR;
        LDB(B0, 1, 0); SCHED; LDA(At, 1, 0); STA(SA(0, 1), 1, t + 2);
        WAIT_L(8); BAR; WAIT_L(0); MMA(0, 0, At, B0); BAR; SCHED;
        LDB(B1, 1, 1); STB(SB(1, 0), 0, t + 3);
        BAR; WAIT_L(0); MMA(0, 1, At, B1); BAR;
        LDA(At, 1, 1); STA(SA(1, 0), 0, t + 3);
        BAR; WAIT_L(0); MMA(1, 0, At, B0); BAR; SCHED;
        STB(SB(1, 1), 1, t + 3);
        WAIT_V(6); BAR; MMA(1, 1, At, B1); BAR;
      }
      { LDB(B0, 0, 0); LDA(At, 0, 0); STA(SA(1, 1), 1, nt - 1);
        BAR; WAIT_L(0); MMA(0, 0, At, B0); BAR;
        LDB(B1, 0, 1); BAR; WAIT_L(0); MMA(0, 1, At, B1); BAR;
        LDA(At, 0, 1); WAIT_V(4); BAR; WAIT_L(0); MMA(1, 0, At, B0); MMA(1, 1, At, B1); BAR; }
      { LDB(B0, 1, 0); LDA(At, 1, 0); WAIT_V(2); BAR; WAIT_L(0); MMA(0, 0, At, B0); BAR;
        LDB(B1, 1, 1); WAIT_V(0); BAR; WAIT_L(0); MMA(0, 1, At, B1); BAR;
        LDA(At, 1, 1); BAR; WAIT_L(0); MMA(1, 0, At, B0); MMA(1, 1, At, B1); BAR; }
      if (wr == 0) BAR;
      if (br < 2) {
        cA = (const char*)(Y + (br + 1) * 1024) + (size_t)pm * 256 * lda * 2;
        cB = (const char*)(W + (size_t)(br + 1) * (SZ_WBR1 / 2)) + (size_t)pn * 256 * ldb * 2;
        ISSUE_PROLOGUE();
      } else {
        ++rnd; have = tile_order(rnd * gridDim.x + blockIdx.x, 64, 8, pm2, pn2);
        if (have) { cA = (const char*)Y + (size_t)pm2 * 256 * lda * 2; cB = (const char*)W + (size_t)pn2 * 256 * ldb * 2; ISSUE_PROLOGUE(); }
      }
      int lane2 = __builtin_amdgcn_mbcnt_hi(~0u, __builtin_amdgcn_mbcnt_lo(~0u, 0u)); asm volatile("" : "+v"(lane2));
      const int cl = wc * 32 + 8 * (lane2 >> 4), fr_e = lane2 & 15;
      const bf16_t* gcur = (const bf16_t*)(ws + OFF_GATES) + br * DM + ocol;
      const bf16_t* gnxt = gcur + DM;
      bf16_t* mbase = (bf16_t*)(ws + OFF_PROJ) + ocol;
#pragma unroll
      for (int ai = 0; ai < 2; ++ai)
#pragma unroll
        for (int mh = 0; mh < 2; ++mh) {
          u32x4 gg[2][2], gn[2][2];
#pragma unroll
          for (int m2 = 0; m2 < 2; ++m2) {
            const int rl = ai * HALF + wr * 64 + (mh * 2 + m2) * 16 + fr_e;
            const size_t go = (size_t)(brow + rl) * GATE_LD + cl;
#pragma unroll
            for (int bj = 0; bj < 2; ++bj) {
              gg[m2][bj] = *(const u32x4*)(gcur + go + bj * HALF);
              if (br < 2) gn[m2][bj] = *(const u32x4*)(gnxt + go + bj * HALF);
            }
          }
#pragma unroll
          for (int m2 = 0; m2 < 2; ++m2) {
            const int m = mh * 2 + m2;
            const int rl = ai * HALF + wr * 64 + m * 16 + fr_e;
            bf16_t* mrow = mbase + (size_t)(brow + rl) * M_LD + cl;
#pragma unroll
            for (int bj = 0; bj < 2; ++bj) {
              const u32x4 g = gg[m2][bj];
              f32x4 v0 = acc[ai][bj][m][0], v1 = acc[ai][bj][m][1];
              if (br < 2) {
                const u32x4 d = gn[m2][bj];
                v0[0] *= bflo(g[0]) * __builtin_amdgcn_rcpf(fmaxf(bflo(d[0]), 1e-20f)); v0[1] *= bfhi(g[0]) * __builtin_amdgcn_rcpf(fmaxf(bfhi(d[0]), 1e-20f));
                v0[2] *= bflo(g[1]) * __builtin_amdgcn_rcpf(fmaxf(bflo(d[1]), 1e-20f)); v0[3] *= bfhi(g[1]) * __builtin_amdgcn_rcpf(fmaxf(bfhi(d[1]), 1e-20f));
                v1[0] *= bflo(g[2]) * __builtin_amdgcn_rcpf(fmaxf(bflo(d[2]), 1e-20f)); v1[1] *= bfhi(g[2]) * __builtin_amdgcn_rcpf(fmaxf(bfhi(d[2]), 1e-20f));
                v1[2] *= bflo(g[3]) * __builtin_amdgcn_rcpf(fmaxf(bflo(d[3]), 1e-20f)); v1[3] *= bfhi(g[3]) * __builtin_amdgcn_rcpf(fmaxf(bfhi(d[3]), 1e-20f));
                acc[ai][bj][m][0] = v0; acc[ai][bj][m][1] = v1;
              } else {
                v0[0] *= fmaxf(bflo(g[0]), 1e-20f); v0[1] *= fmaxf(bfhi(g[0]), 1e-20f); v0[2] *= fmaxf(bflo(g[1]), 1e-20f); v0[3] *= fmaxf(bfhi(g[1]), 1e-20f);
                v1[0] *= fmaxf(bflo(g[2]), 1e-20f); v1[1] *= fmaxf(bfhi(g[2]), 1e-20f); v1[2] *= fmaxf(bflo(g[3]), 1e-20f); v1[3] *= fmaxf(bfhi(g[3]), 1e-20f);
                u32x4 o; o[0] = pk_bf16(v0[0], v0[1]); o[1] = pk_bf16(v0[2], v0[3]); o[2] = pk_bf16(v1[0], v1[1]); o[3] = pk_bf16(v1[2], v1[3]);
                *(u32x4*)(mrow + bj * HALF) = o;
              }
            }
          }
        }
    }
    pm = pm2; pn = pn2;
  }
}

constexpr int KP = 272, VP = 320, KBUF = 64 * KP, VBUF = 64 * VP;
constexpr int AT_V = 3 * KBUF, AT_BT = AT_V + 3 * VBUF, AT_KB = AT_BT + 16384, AT_SM = AT_KB + 8192, AT_FL = AT_SM + 1024;

DI int rel_bucket_i(int n) {
  if (n < 16) return n;
  return 16 + (n >= 22) + (n >= 30) + (n >= 40) + (n >= 54) + (n >= 73) + (n >= 99) + (n >= 134) + (n >= 182) + (n >= 246) + (n >= 332) + (n >= 450) + (n >= 609) + (n >= 825) + (n >= 1117) + (n >= 1513);
}

template <int MODE> DI void attn_unit(KParams p, int b, int h, int qt, char* shm) {
  const int tid = opaque_tid(), lane = tid & 63, w = __builtin_amdgcn_readfirstlane(tid >> 6), r = lane & 31, hh = lane >> 5;
  const bf16_t* proj = (const bf16_t*)(p->ws + OFF_PROJ);
  const int qcol = (MODE == 0 ? 0 : 4096) + h * 128, kcol = qcol + 1024, vcol = qcol + 2048;
  const size_t tok0 = (size_t)b * SEQ;
  const int q0 = qt * 256, q0w = q0 + 32 * w, qpos = q0w + r;
  const float SC = 0.08838834764831845f * LOG2E;
  float* btab = (float*)(shm + AT_BT);
  int* flags = (int*)(shm + AT_FL);
  __syncthreads();
  bf16x8 qf[8];
  { const bf16_t* qp = proj + (tok0 + qpos) * PROJ_LD + qcol + 8 * hh;
#pragma unroll
    for (int s = 0; s < 8; ++s) qf[s] = *(const bf16x8*)(qp + 16 * s); }
  unsigned mymask = 0;
  if (MODE == 0) {
    float* kbl = (float*)(shm + AT_KB); unsigned* selm = (unsigned*)(shm + AT_SM);
    { const int kblk = tid >> 5, part = tid & 31;
      const float* kbg = (const float*)(p->ws + OFF_KBAR) + ((size_t)(b * 16 + kblk) * 2) * 1024 + h * 128 + part * 4;
      const f32x4 k0 = *(const f32x4*)kbg, k1 = *(const f32x4*)(kbg + 1024);
      *(f32x4*)(kbl + kblk * 128 + part * 4) = (k0 + k1) * (1.f / 256.f); }
#pragma unroll
    for (int i = 0; i < 8; ++i) { const int d = tid + 512 * i; btab[d] = p->rel_bias[h * 32 + rel_bucket_i(d)] * LOG2E; }
    __syncthreads();
    const int ql = tid >> 1, half = tid & 1, own = qt;
    float g[8] = {0.f, 0.f, 0.f, 0.f, 0.f, 0.f, 0.f, 0.f};
    if (own > 0) {
      const bf16_t* qp = proj + (tok0 + q0 + ql) * PROJ_LD + qcol;
#pragma unroll 2
      for (int dc = 0; dc < 16; ++dc) {
        const u32x4 qv = *(const u32x4*)(qp + dc * 8);
        float qq[8];
#pragma unroll
        for (int e = 0; e < 4; ++e) { qq[2 * e] = bflo(qv[e]); qq[2 * e + 1] = bfhi(qv[e]); }
#pragma unroll
        for (int n = 0; n < 8; ++n) {
          const float* kr = kbl + (half * 8 + n) * 128 + dc * 8;
          const f32x4 k0 = *(const f32x4*)kr, k1 = *(const f32x4*)(kr + 4);
          g[n] += qq[0] * k0[0] + qq[1] * k0[1] + qq[2] * k0[2] + qq[3] * k0[3] + qq[4] * k1[0] + qq[5] * k1[1] + qq[6] * k1[2] + qq[7] * k1[3];
        }
      }
    }
    float all[16];
#pragma unroll
    for (int n = 0; n < 8; ++n) { const float go = __shfl_xor(g[n], 1); all[n] = half ? go : g[n]; all[8 + n] = half ? g[n] : go; }
    unsigned mask = 1u << own;
    const int nsel = own < 3 ? own : 3;
#pragma unroll
    for (int t = 0; t < 3; ++t) {
      if (t < nsel) {
        float best = -3.0e38f; int bi = 0;
#pragma unroll
        for (int n = 0; n < 16; ++n) { const bool ok = (n < own) && !((mask >> n) & 1u) && (all[n] > best); best = ok ? all[n] : best; bi = ok ? n : bi; }
        mask |= 1u << bi;
      }
    }
    if (half == 0) selm[ql] = mask;
    __syncthreads();
    mymask = selm[32 * w + r];
  } else {
    if (tid < 16) flags[tid] = 0;
  }
  bf16x8 tf[2];
  if (MODE == 1) {
#pragma unroll
    for (int s = 0; s < 2; ++s)
#pragma unroll
      for (int j = 0; j < 8; ++j) { const int k = 16 * s + 8 * (j >> 2) + 4 * hh + (j & 3); tf[s][j] = (k >= r) ? (short)0x3F80 : (short)0; }
  }
  f32x16 o[4];
#pragma unroll
  for (int dt = 0; dt < 4; ++dt)
#pragma unroll
    for (int i = 0; i < 16; ++i) o[dt][i] = 0.f;
  float mrun = -1e30f, lrun = 0.f, carry = 0.f;
  const int ntiles = 4 * qt + 4;
  u32x4 kreg[2], vreg[2];
#define GLOAD(kst) do { _Pragma("unroll") for (int _i = 0; _i < 2; ++_i) { const int _c = tid + 512 * _i, _key = _c >> 4, _part = _c & 15; \
      const bf16_t* _rp = proj + (tok0 + (kst) + _key) * PROJ_LD; kreg[_i] = *(const u32x4*)(_rp + kcol + _part * 8); vreg[_i] = *(const u32x4*)(_rp + vcol + _part * 8); } } while (0)
#define LSTORE(buf) do { _Pragma("unroll") for (int _i = 0; _i < 2; ++_i) { const int _c = tid + 512 * _i, _key = _c >> 4, _part = _c & 15; \
      *(u32x4*)(shm + (buf) * KBUF + _key * KP + _part * 16) = kreg[_i]; *(u32x4*)(shm + AT_V + (buf) * VBUF + _key * VP + _part * 16) = vreg[_i]; } } while (0)
#define KST(it) (MODE == 0 ? 64 * (it) : 64 * (ntiles - 1 - (it)))
  GLOAD(KST(0)); LSTORE(0); __syncthreads();
  const int i16 = lane & 15, q4 = i16 >> 2, p4 = i16 & 3, blk16 = (lane >> 4) & 1;
  bool wdone = false;
  const bool defer = (MODE == 0) && (w >= 4);
  bf16x8 pf[4]; bool pend = false; int pendbuf = 0;
#pragma unroll
  for (int ks = 0; ks < 4; ++ks) pf[ks] = (bf16x8){0, 0, 0, 0, 0, 0, 0, 0};
#define PV_STEP(PF, B) do { const char* _vb0 = shm + AT_V + (B) * VBUF + (4 * hh + q4) * VP + 32 * blk16 + 8 * p4; \
    _Pragma("unroll") for (int dt = 0; dt < 4; ++dt) _Pragma("unroll") for (int ks = 0; ks < 4; ++ks) { \
      const char* _vb = _vb0 + (ks * 16) * VP + dt * 64; \
      const s16x4 _lo = __builtin_amdgcn_ds_read_tr16_b64_v4i16((LAS s16x4*)(_vb)); \
      const s16x4 _hi = __builtin_amdgcn_ds_read_tr16_b64_v4i16((LAS s16x4*)(_vb + 8 * VP)); \
      o[dt] = mfma32(__builtin_shufflevector(_lo, _hi, 0, 1, 2, 3, 4, 5, 6, 7), PF[ks], o[dt]); } } while (0)
  int buf = 0;
  for (int it = 0; it < ntiles; ++it) {
    const int kst = KST(it), nbuf = (buf == 2) ? 0 : buf + 1;
    if (MODE == 1 && it > 0) {
      const int* fl = flags + ((it - 1) & 1) * 8;
      const int alld = fl[0] & fl[1] & fl[2] & fl[3] & fl[4] & fl[5] & fl[6] & fl[7];
      if (alld) break;
    }
    if (it + 1 < ntiles) GLOAD(KST(it + 1));
    if (defer && pend) { PV_STEP(pf, pendbuf); pend = false; }
    bool active;
    bool sel = true;
    if (MODE == 0) {
      const int j = kst >> 8;
      if (j == qt) active = (kst - q0) <= 32 * w + 31;
      else { sel = (mymask >> j) & 1u; active = __builtin_amdgcn_ballot_w64(sel) != 0ull; }
    } else {
      active = !wdone && (kst <= q0w + 31);
    }
    if (active) {
      f32x16 st[2];
#pragma unroll
      for (int sub = 0; sub < 2; ++sub) {
        f32x16 a16;
#pragma unroll
        for (int i = 0; i < 16; ++i) a16[i] = 0.f;
        const char* kb = shm + buf * KBUF + (sub * 32 + r) * KP + hh * 16;
#pragma unroll
        for (int s = 0; s < 8; ++s) a16 = mfma32(*(const bf16x8*)(kb + s * 32), qf[s], a16);
        st[sub] = a16;
      }
      if (MODE == 0) {
        __builtin_amdgcn_s_setprio(1);
        float mx = -1e30f;
        const int dmin = q0w - (kst + 63), dmax = q0w + 31 - kst;
        const int bl = rel_bucket_i(dmin < 0 ? 0 : dmin), bh = rel_bucket_i(dmax);
        if ((kst >> 8) != qt && dmin >= 16 && bh - bl <= 1) {
          int T = 1513;
          if (dmin < 1117) T = 1117; if (dmin < 825) T = 825; if (dmin < 609) T = 609; if (dmin < 450) T = 450; if (dmin < 332) T = 332;
          if (dmin < 246) T = 246; if (dmin < 182) T = 182; if (dmin < 134) T = 134; if (dmin < 99) T = 99; if (dmin < 73) T = 73;
          if (dmin < 54) T = 54; if (dmin < 40) T = 40; if (dmin < 30) T = 30; if (dmin < 22) T = 22;
          if (bh == bl) T = -(1 << 30);
          const float bhi = btab[dmax], blo = btab[dmin];
          const float hi_l = sel ? bhi : -1e30f, lo_l = sel ? blo : -1e30f;
          const int dist0 = qpos - kst - 4 * hh;
#pragma unroll
          for (int sub = 0; sub < 2; ++sub)
#pragma unroll
            for (int i = 0; i < 16; ++i) {
              const int c = sub * 32 + (i & 3) + 8 * (i >> 2);
              const float bias = (dist0 >= T + c) ? hi_l : lo_l;
              const float v = st[sub][i] * SC + bias;
              st[sub][i] = v; mx = fmaxf(mx, v);
            }
        } else {
#pragma unroll
          for (int sub = 0; sub < 2; ++sub)
#pragma unroll
            for (int i = 0; i < 16; ++i) {
              const int key = kst + sub * 32 + (i & 3) + 8 * (i >> 2) + 4 * hh;
              const int dist = qpos - key;
              const bool valid = sel && (dist >= 0);
              const float bias = btab[dist < 0 ? 0 : dist];
              const float v = valid ? st[sub][i] * SC + bias : -1e30f;
              st[sub][i] = v; mx = fmaxf(mx, v);
            }
        }
        mx = fmaxf(mx, __shfl_xor(mx, 32));
        const float mnew = fmaxf(mrun, mx);
        float ps = 0.f;
#pragma unroll
        for (int sub = 0; sub < 2; ++sub)
#pragma unroll
          for (int i = 0; i < 16; ++i) { const float pv = fexp2(st[sub][i] - mnew); st[sub][i] = pv; ps += pv; }
        if (__builtin_amdgcn_ballot_w64(mnew > mrun) != 0ull) {
          const float alpha = fexp2(mrun - mnew);
          mrun = mnew;
          lrun *= alpha;
#pragma unroll
          for (int dt = 0; dt < 4; ++dt)
#pragma unroll
            for (int i = 0; i < 16; ++i) o[dt][i] *= alpha;
        }
        lrun += ps;
        __builtin_amdgcn_s_setprio(0);
      } else {
#pragma unroll
        for (int sub = 1; sub >= 0; --sub) {
          f32x16 sp;
#pragma unroll
          for (int i = 0; i < 16; ++i) {
            const int key = kst + sub * 32 + (i & 3) + 8 * (i >> 2) + 4 * hh;
            const bool valid = key < qpos;
            const float z = st[sub][i] * SC;
            const float s = fmaxf(z, 0.f) + flog2(1.f + fexp2(-fabsf(z)));
            sp[i] = valid ? s : 0.f; st[sub][i] = z;
          }
          f32x16 c;
#pragma unroll
          for (int i = 0; i < 16; ++i) c[i] = carry;
#pragma unroll
          for (int s2 = 0; s2 < 2; ++s2) {
            u32x4 hi, lo;
#pragma unroll
            for (int jj = 0; jj < 4; ++jj) {
              const float a0 = sp[8 * s2 + 2 * jj], a1 = sp[8 * s2 + 2 * jj + 1];
              const unsigned hv = pk_bf16(a0, a1);
              hi[jj] = hv; lo[jj] = pk_bf16(a0 - bflo(hv), a1 - bfhi(hv));
            }
            c = mfma32(tf[s2], __builtin_bit_cast(bf16x8, hi), c);
            c = mfma32(tf[s2], __builtin_bit_cast(bf16x8, lo), c);
          }
          carry = __shfl(c[0], r);
#pragma unroll
          for (int i = 0; i < 16; ++i) {
            const int key = kst + sub * 32 + (i & 3) + 8 * (i >> 2) + 4 * hh;
            const bool valid = key < qpos;
            st[sub][i] = valid ? fexp2(st[sub][i] - c[i]) : 0.f;
          }
        }
        wdone = __builtin_amdgcn_ballot_w64(carry > 152.f) == ~0ull;
      }
#pragma unroll
      for (int ks = 0; ks < 4; ++ks) {
        u32x4 t;
#pragma unroll
        for (int jj = 0; jj < 4; ++jj) t[jj] = pk_bf16(st[ks >> 1][8 * (ks & 1) + 2 * jj], st[ks >> 1][8 * (ks & 1) + 2 * jj + 1]);
        pf[ks] = __builtin_bit_cast(bf16x8, t);
      }
      if (!defer) { PV_STEP(pf, buf); }
      else { pend = true; pendbuf = buf; }
    }
    if (MODE == 1) { if (lane == 0) flags[(it & 1) * 8 + w] = (wdone || (kst == 0)) ? 1 : 0; }
    if (it + 1 < ntiles) LSTORE(nbuf);
    __syncthreads();
    buf = nbuf;
  }
  if (defer && pend) { PV_STEP(pf, pendbuf); }
#undef PV_STEP
  float inv = 1.f;
  if (MODE == 0) { const float lt = lrun + __shfl_xor(lrun, 32); inv = 1.f / lt; }
  bf16_t* yp = (bf16_t*)(p->ws + OFF_Y) + (tok0 + qpos) * Y_LD + (MODE == 0 ? 0 : 2048) + h * 128 + 4 * hh;
#pragma unroll
  for (int dt = 0; dt < 4; ++dt)
#pragma unroll
    for (int g = 0; g < 4; ++g) {
      u32x2 ov; ov[0] = pk_bf16(o[dt][4 * g] * inv, o[dt][4 * g + 1] * inv); ov[1] = pk_bf16(o[dt][4 * g + 2] * inv, o[dt][4 * g + 3] * inv);
      *(u32x2*)(yp + dt * 32 + 8 * g) = ov;
    }
#undef GLOAD
#undef LSTORE
#undef KST
}

constexpr int SBW_K = 32 * KP, SBW_V = 32 * VP, SBW_LDS = SBW_K + SBW_V;
DI void sb_unit(KParams p, int b, int h, int qt, char* shm) {
  const int tid = opaque_tid(), lane = tid & 63, w = __builtin_amdgcn_readfirstlane(tid >> 6), r = lane & 31, hh = lane >> 5;
  const bf16_t* proj = (const bf16_t*)(p->ws + OFF_PROJ);
  const int qcol = 4096 + h * 128, kcol = qcol + 1024, vcol = qcol + 2048;
  const size_t tok0 = (size_t)b * SEQ;
  const int q0w = qt * 256 + 32 * w, qpos = q0w + r;
  const float SC = 0.08838834764831845f * LOG2E;
  char* kl = shm + w * SBW_LDS; char* vl = kl + SBW_K;
  __syncthreads();
  bf16x8 qf[8];
  { const bf16_t* qp = proj + (tok0 + qpos) * PROJ_LD + qcol + 8 * hh;
#pragma unroll
    for (int s = 0; s < 8; ++s) qf[s] = *(const bf16x8*)(qp + 16 * s); }
  bf16x8 tf[2];
#pragma unroll
  for (int s = 0; s < 2; ++s)
#pragma unroll
    for (int j = 0; j < 8; ++j) { const int k = 16 * s + 8 * (j >> 2) + 4 * hh + (j & 3); tf[s][j] = (k >= r) ? (short)0x3F80 : (short)0; }
  f32x16 o[4];
#pragma unroll
  for (int dt = 0; dt < 4; ++dt)
#pragma unroll
    for (int i = 0; i < 16; ++i) o[dt][i] = 0.f;
  float carry = 0.f;
  const int i16 = lane & 15, q4 = i16 >> 2, p4 = i16 & 3, blk16 = (lane >> 4) & 1;
  u32x4 kreg[4], vreg[4];
#define SB_GLOAD(kst) do { _Pragma("unroll") for (int _i = 0; _i < 4; ++_i) { const int _c = lane + 64 * _i, _key = _c >> 3, _part = _c & 7; \
      const bf16_t* _rp = proj + (tok0 + (kst) + _key) * PROJ_LD; kreg[_i] = *(const u32x4*)(_rp + kcol + _part * 16); vreg[_i] = *(const u32x4*)(_rp + vcol + _part * 16); } } while (0)
  u32x4 kreg2[4], vreg2[4];
#define SB_GLOAD2(kst) do { _Pragma("unroll") for (int _i = 0; _i < 4; ++_i) { const int _c = lane + 64 * _i, _key = _c >> 3, _part = _c & 7; \
      const bf16_t* _rp = proj + (tok0 + (kst) + _key) * PROJ_LD; kreg2[_i] = *(const u32x4*)(_rp + kcol + _part * 16 + 8); vreg2[_i] = *(const u32x4*)(_rp + vcol + _part * 16 + 8); } } while (0)
#define SB_LSTORE() do { _Pragma("unroll") for (int _i = 0; _i < 4; ++_i) { const int _c = lane + 64 * _i, _key = _c >> 3, _part = _c & 7; \
      *(u32x4*)(kl + _key * KP + _part * 32) = kreg[_i]; *(u32x4*)(kl + _key * KP + _part * 32 + 16) = kreg2[_i]; \
      *(u32x4*)(vl + _key * VP + _part * 32) = vreg[_i]; *(u32x4*)(vl + _key * VP + _part * 32 + 16) = vreg2[_i]; } } while (0)
  int kst = q0w;
  SB_GLOAD(kst); SB_GLOAD2(kst);
  for (;;) {
    SB_LSTORE();
    const int knext = kst - 32;
    if (knext >= 0) { SB_GLOAD(knext); SB_GLOAD2(knext); }
    f32x16 st;
#pragma unroll
    for (int i = 0; i < 16; ++i) st[i] = 0.f;
    { const char* kb = kl + r * KP + hh * 16;
#pragma unroll
      for (int s = 0; s < 8; ++s) st = mfma32(*(const bf16x8*)(kb + s * 32), qf[s], st); }
    f32x16 sp;
#pragma unroll
    for (int i = 0; i < 16; ++i) {
      const int key = kst + (i & 3) + 8 * (i >> 2) + 4 * hh;
      const float z = st[i] * SC;
      const float s = fmaxf(z, 0.f) + flog2(1.f + fexp2(-fabsf(z)));
      sp[i] = (key < qpos) ? s : 0.f; st[i] = z;
    }
    f32x16 c;
#pragma unroll
    for (int i = 0; i < 16; ++i) c[i] = carry;
#pragma unroll
    for (int s2 = 0; s2 < 2; ++s2) {
      u32x4 hi, lo;
#pragma unroll
      for (int jj = 0; jj < 4; ++jj) {
        const float a0 = sp[8 * s2 + 2 * jj], a1 = sp[8 * s2 + 2 * jj + 1];
        const unsigned hv = pk_bf16(a0, a1);
        hi[jj] = hv; lo[jj] = pk_bf16(a0 - bflo(hv), a1 - bfhi(hv));
      }
      c = mfma32(tf[s2], __builtin_bit_cast(bf16x8, hi), c);
      c = mfma32(tf[s2], __builtin_bit_cast(bf16x8, lo), c);
    }
    carry = __shfl(c[0], r);
    bf16x8 pf[2];
#pragma unroll
    for (int ks = 0; ks < 2; ++ks) {
      u32x4 t;
#pragma unroll
      for (int jj = 0; jj < 4; ++jj) {
        const int i0 = 8 * ks + 2 * jj, i1 = i0 + 1;
        const int key0 = kst + (i0 & 3) + 8 * (i0 >> 2) + 4 * hh, key1 = kst + (i1 & 3) + 8 * (i1 >> 2) + 4 * hh;
        const float a0 = (key0 < qpos) ? fexp2(st[i0] - c[i0]) : 0.f, a1 = (key1 < qpos) ? fexp2(st[i1] - c[i1]) : 0.f;
        t[jj] = pk_bf16(a0, a1);
      }
      pf[ks] = __builtin_bit_cast(bf16x8, t);
    }
    const char* vb0 = vl + (4 * hh + q4) * VP + 32 * blk16 + 8 * p4;
#pragma unroll
    for (int dt = 0; dt < 4; ++dt)
#pragma unroll
      for (int ks = 0; ks < 2; ++ks) {
        const char* vb = vb0 + (ks * 16) * VP + dt * 64;
        const s16x4 lo = __builtin_amdgcn_ds_read_tr16_b64_v4i16((LAS s16x4*)(vb));
        const s16x4 hi = __builtin_amdgcn_ds_read_tr16_b64_v4i16((LAS s16x4*)(vb + 8 * VP));
        o[dt] = mfma32(__builtin_shufflevector(lo, hi, 0, 1, 2, 3, 4, 5, 6, 7), pf[ks], o[dt]);
      }
    if (knext < 0 || __builtin_amdgcn_ballot_w64(carry > 152.f) == ~0ull) break;
    kst = knext;
  }
#undef SB_GLOAD
#undef SB_GLOAD2
#undef SB_LSTORE
  bf16_t* yp = (bf16_t*)(p->ws + OFF_Y) + (tok0 + qpos) * Y_LD + 2048 + h * 128 + 4 * hh;
#pragma unroll
  for (int dt = 0; dt < 4; ++dt)
#pragma unroll
    for (int g = 0; g < 4; ++g) {
      u32x2 ov; ov[0] = pk_bf16(o[dt][4 * g], o[dt][4 * g + 1]); ov[1] = pk_bf16(o[dt][4 * g + 2], o[dt][4 * g + 3]);
      *(u32x2*)(yp + dt * 32 + 8 * g) = ov;
    }
}

DI void attention_phase(KParams p, char* shm) {
  for (int k = blockIdx.x; k < 256; k += gridDim.x)
    for (int s = 0; s < 2; ++s) { const int u = s ? 511 - k : k; attn_unit<0>(p, (u & 31) >> 3, u & 7, 15 - (u >> 5), shm); }
  for (int k = blockIdx.x; k < 256; k += gridDim.x)
    for (int s = 0; s < 2; ++s) { const int u = s ? 511 - k : k; sb_unit(p, (u & 31) >> 3, u & 7, 15 - (u >> 5), shm); }
}

constexpr int NPHASE = 15;
DI void run_phase(KParams p, int ph, char* shm) {
  asm volatile("" : "+s"(p));
  char* ws = p->ws;
  const int l = ph == 0 ? 0 : (ph - 1) / 7, sp0 = ph == 0 ? -1 : (ph - 1) % 7, sp = sp0 >= 1 ? sp0 + 1 : sp0;
  if (ph == 0 || (sp == 7 && l == 0)) { convert_layer(p, ph == 0 ? 0 : 1, shm); if (ph == 0) x_prep(p); return; }
  if (sp == 7) { final_norm(p); return; }
  if (sp == 2) attention_phase(p, shm);
  if (sp == 3) { branch_phase(p, shm); return; }
  const bf16_t* A; const bf16_t* Bt; int lda, ldb, K, nN, kind, nsub = 1, acs = 0, oc0 = 0, ocs = 256; const float* hin = nullptr;
  size_t asub = 0, bsub = 0;
  if (sp == 0) { A = (const bf16_t*)(ws + OFF_XB); lda = XB_LD; Bt = (const bf16_t*)(ws + OFF_WIN); ldb = DM; K = DM; nN = 52; kind = EPI_IN; }
  else if (sp == 2) { A = (const bf16_t*)(ws + OFF_P); lda = P_LD; Bt = (const bf16_t*)(ws + OFF_WPOOL); ldb = 256; K = 256; nN = 4; kind = EPI_POOL; acs = 256; oc0 = 1024; }
  else if (sp == 3) { A = (const bf16_t*)(ws + OFF_Y); lda = Y_LD; Bt = (const bf16_t*)(ws + OFF_WBR); ldb = 1024; K = 1024; nN = 8; kind = EPI_BR; nsub = 3; asub = 1024; bsub = SZ_WBR1 / 2; }
  else if (sp == 4) { A = (const bf16_t*)(ws + OFF_PROJ); lda = M_LD; Bt = (const bf16_t*)(ws + OFF_WOUT); ldb = DM; K = DM; nN = 8; kind = EPI_RES; }
  else if (sp == 5) { A = (const bf16_t*)(ws + OFF_XB); lda = XB_LD; Bt = (const bf16_t*)(ws + OFF_WGU); ldb = DM; K = DM; nN = 44; kind = EPI_FFN1; ocs = 128; }
  else { A = (const bf16_t*)(ws + OFF_PROJ); lda = ACT_LD; Bt = (const bf16_t*)(ws + OFF_WDOWN); ldb = DFF; K = DFF; nN = 8; kind = EPI_RES; }
  gemm_phase(p, A, lda, Bt, ldb, K, nN, kind, nsub, asub, bsub, acs, oc0, ocs, hin, shm);
}

constexpr int LDS_BYTES = 8 * SBW_LDS + 16 > GEMM_LDS + 2048 + 16 ? 8 * SBW_LDS + 16 : GEMM_LDS + 2048 + 16;

__global__ void __launch_bounds__(512, 2) hybrid_megakernel(Params p_arg) {
  extern __shared__ __attribute__((aligned(16))) char shm[];
  KParams kp = (KParams)__builtin_amdgcn_kernarg_segment_ptr();
  const int phase_lo = kp->phase_lo, phase_hi = kp->phase_hi;
  volatile LAS unsigned* xst = (volatile LAS unsigned*)(LAS char*)(shm + LDS_BYTES - 16);
  const bool multi = phase_hi - phase_lo > 1;
  XcdBarrier xb{};
  if (multi) {
    if (threadIdx.x == 0) { xst[0] = 0u; xst[1] = 0u; }
    __syncthreads();
    xb = xcd_barrier_post((unsigned*)(kp->ws + OFF_BAR), xst);
  }
  for (int ph = phase_lo; ph < phase_hi; ++ph) {
    if (ph > phase_lo) { if (ph == 1) cg::this_grid().sync(); else xcd_barrier(xb, (unsigned*)(kp->ws + OFF_BAR)); }
    run_phase(kp, ph, shm);
  }
}

#ifndef SINGLE_LAUNCH
#define SINGLE_LAUNCH 1
#endif

extern "C" void kernel_launch(void* const* d_in, const int* in_sizes, int n_in, void* d_out, int out_size, void* d_ws, size_t ws_size, hipStream_t stream) {
  static int grid_blocks = 0;
  if (!grid_blocks) {
    hipFuncSetAttribute((const void*)hybrid_megakernel, hipFuncAttributeMaxDynamicSharedMemorySize, LDS_BYTES);
    int dev = 0, cus = 0, per_cu = 0;
    hipGetDevice(&dev);
    hipDeviceGetAttribute(&cus, hipDeviceAttributeMultiprocessorCount, dev);
    hipOccupancyMaxActiveBlocksPerMultiprocessor(&per_cu, hybrid_megakernel, 512, LDS_BYTES);
    if (per_cu < 1) per_cu = 1;
    grid_blocks = cus * per_cu;
    if (ws_size < WS_NEED) fprintf(stderr, "workspace too small: %zu < %zu\n", ws_size, (size_t)WS_NEED);
  }
  Params p{};
  p.x = (const float*)d_in[0]; p.norm_mix = (const float*)d_in[1]; p.norm_ffn = (const float*)d_in[2]; p.w_in = (const float*)d_in[3];
  p.w_pool = (const float*)d_in[4]; p.pool_scale = (const float*)d_in[5]; p.w_br_a = (const float*)d_in[6]; p.w_br_b = (const float*)d_in[7];
  p.w_br_c = (const float*)d_in[8]; p.w_out = (const float*)d_in[9]; p.w_gate = (const float*)d_in[10]; p.w_up = (const float*)d_in[11];
  p.w_down = (const float*)d_in[12]; p.rel_bias = (const float*)d_in[13]; p.norm_final = (const float*)d_in[14];
  p.out = (float*)d_out; p.ws = (char*)d_ws;
#if SINGLE_LAUNCH
  hipMemsetAsync((char*)d_ws + OFF_BAR, 0, 16384, stream);
  p.phase_lo = 0; p.phase_hi = NPHASE;
  void* args[] = {&p};
  hipError_t e = hipLaunchCooperativeKernel((const void*)hybrid_megakernel, dim3(grid_blocks), dim3(512), args, LDS_BYTES, stream);
  if (e != hipSuccess) fprintf(stderr, "cooperative launch failed: %s (grid %d)\n", hipGetErrorString(e), grid_blocks);
#else
  for (int ph = 0; ph < NPHASE; ++ph) {
    p.phase_lo = ph; p.phase_hi = ph + 1;
    hipLaunchKernelGGL(hybrid_megakernel, dim3(grid_blocks), dim3(512), LDS_BYTES, stream, p);
  }
#endif
}
```

```cpp
#include <hip/hip_runtime.h>
#include <hip/hip_cooperative_groups.h>
#include <cstdio>
namespace cg = cooperative_groups;
#ifndef REP_N
#define REP_N 1
#define REP_PH 0
#endif

#define LAS __attribute__((address_space(3)))
#define DI __device__ __forceinline__
typedef unsigned short bf16_t;
typedef short bf16x8 __attribute__((ext_vector_type(8)));
typedef short s16x4 __attribute__((ext_vector_type(4)));
typedef float f32x4 __attribute__((ext_vector_type(4)));
typedef float f32x16 __attribute__((ext_vector_type(16)));
typedef unsigned u32x4 __attribute__((ext_vector_type(4)));
typedef unsigned u32x2 __attribute__((ext_vector_type(2)));

constexpr int DM = 2048, NBATCH = 4, SEQ = 4096, MTOK = NBATCH * SEQ, INW = 13312, DFF = 5632;
constexpr int PAD = 128;
constexpr int PROJ_W = 7168, PROJ_LD = PROJ_W + PAD, GATE_LD = 6144 + PAD, Y_LD = 3072 + PAD, XB_LD = DM + PAD, M_LD = DM + PAD, ACT_LD = DFF + PAD, P_LD = 1024 + PAD;
constexpr float LOG2E = 1.4426950408889634f;

constexpr size_t SZ_WIN = (size_t)INW * DM * 2;
constexpr size_t SZ_WPOOL = (size_t)4 * 256 * 256 * 2;
constexpr size_t SZ_WBR1 = (size_t)DM * 1024 * 2;
constexpr size_t SZ_WOUT = (size_t)DM * DM * 2;
constexpr size_t SZ_WGU = (size_t)2 * DFF * DM * 2;
constexpr size_t SZ_WDOWN = (size_t)DM * DFF * 2;
constexpr size_t OFF_WIN = 0;
constexpr size_t OFF_WPOOL = OFF_WIN + SZ_WIN;
constexpr size_t OFF_WBR = OFF_WPOOL + SZ_WPOOL;
constexpr size_t OFF_WOUT = OFF_WBR + 3 * SZ_WBR1;
constexpr size_t OFF_WGU = OFF_WOUT + SZ_WOUT;
constexpr size_t OFF_WDOWN = OFF_WGU + SZ_WGU;
constexpr size_t OFF_PROJ = OFF_WDOWN + SZ_WDOWN;
constexpr size_t OFF_GATES = OFF_PROJ + (size_t)MTOK * PROJ_LD * 2;
constexpr size_t OFF_XB = OFF_GATES + (size_t)MTOK * GATE_LD * 2;
constexpr size_t OFF_Y = OFF_XB + (size_t)MTOK * XB_LD * 2;
constexpr size_t OFF_P = OFF_Y + (size_t)MTOK * Y_LD * 2;
constexpr size_t OFF_SSQ = OFF_P + (size_t)MTOK * P_LD * 2;
constexpr size_t OFF_KBAR = OFF_SSQ + (size_t)MTOK * 32 * 4;
constexpr size_t OFF_BAR = OFF_KBAR + (size_t)4 * 16 * 2 * 1024 * 4;
constexpr size_t WS_NEED = OFF_BAR + 16384;

struct Params {
  const float *x, *norm_mix, *norm_ffn, *w_in, *w_pool, *pool_scale, *w_br_a, *w_br_b, *w_br_c, *w_out, *w_gate, *w_up, *w_down, *rel_bias, *norm_final;
  float* out;
  char* ws;
  int phase_lo, phase_hi;
};
typedef const __attribute__((address_space(4))) Params* KParams;

DI const char* uni_ptr(const char* q) { const unsigned long long v = (unsigned long long)q; const unsigned lo = __builtin_amdgcn_readfirstlane((unsigned)v), hi = __builtin_amdgcn_readfirstlane((unsigned)(v >> 32)); return (const char*)(((unsigned long long)hi << 32) | lo); }
DI int opaque_tid() { int t = threadIdx.x; asm volatile("" : "+v"(t)); return t; }
DI unsigned pk_bf16(float lo, float hi) { unsigned r; asm("v_cvt_pk_bf16_f32 %0, %1, %2" : "=v"(r) : "v"(lo), "v"(hi)); return r; }
DI float bflo(unsigned v) { return __uint_as_float(v << 16); }
DI float bfhi(unsigned v) { return __uint_as_float(v & 0xffff0000u); }
DI float fexp2(float x) { return __builtin_amdgcn_exp2f(x); }
DI float flog2(float x) { return __builtin_amdgcn_logf(x); }
DI f32x16 mfma32(bf16x8 a, bf16x8 b, f32x16 c) { return __builtin_amdgcn_mfma_f32_32x32x16_bf16(a, b, c, 0, 0, 0); }


#define XB_TMO      128
#define XB_XCNT(j)  (256  + 64 * (j))
#define XB_XSUB(j)  (1280 + 64 * (j))
#define XB_XGEN(j)  (2304 + 64 * (j))
#define XB_TOP      3328
#define XB_TOPGEN   3392
#define XCD_BAR_WORDS 3456
#define XB_SPIN_CAP (1u << 18)
DI unsigned xb_ld(unsigned* q) { return __hip_atomic_load(q, __ATOMIC_RELAXED, __HIP_MEMORY_SCOPE_AGENT); }
DI unsigned xb_add(unsigned* q, unsigned v) { return __hip_atomic_fetch_add(q, v, __ATOMIC_RELAXED, __HIP_MEMORY_SCOPE_AGENT); }
DI unsigned xb_xcc_id() { return (unsigned)__builtin_amdgcn_s_getreg((3 << 11) | 20) & 0xFu; }
#define XB_SPIN(cond, bar) do { unsigned _sp = 0; while (cond) { __builtin_amdgcn_s_sleep(1); \
    if ((++_sp & 255u) == 0u) { if (xb_ld(&(bar)[XB_TMO])) break; if (_sp > XB_SPIN_CAP) { atomicAdd(&(bar)[XB_TMO], 1u); break; } } } } while (0)
struct XcdBarrier { unsigned* bar; unsigned x; volatile LAS unsigned* st; };
DI XcdBarrier xcd_barrier_post(unsigned* bar, volatile LAS unsigned* st) {
  XcdBarrier b; b.bar = bar; b.x = xb_xcc_id(); b.st = st;
  if (threadIdx.x == 0) (void)xb_add(&bar[XB_XCNT(b.x)], 1u);
  return b;
}
DI void xcd_barrier_complete(unsigned* bar, unsigned x, unsigned& nloc, unsigned& nx) {
  const unsigned G = gridDim.x * gridDim.y * gridDim.z;
  unsigned sum, cnt, mine, sp = 0u;
  for (;;) {
    sum = 0u; cnt = 0u; mine = 0u;
#pragma unroll
    for (unsigned j = 0; j < 16; ++j) { const unsigned c = xb_ld(&bar[XB_XCNT(j)]); sum += c; cnt += (c > 0u) ? 1u : 0u; mine = (j == x) ? c : mine; }
    if (sum == G) break;
    __builtin_amdgcn_s_sleep(1);
    if ((++sp & 255u) == 0u) { if (xb_ld(&bar[XB_TMO])) break; if (sp > XB_SPIN_CAP) { atomicAdd(&bar[XB_TMO], 1u); break; } }
  }
  nloc = mine > 0u ? mine : 1u; nx = cnt > 0u ? cnt : 1u;
}
DI void xcd_barrier(const XcdBarrier& b, unsigned* bar_in) {
  asm volatile("s_waitcnt vmcnt(0)" ::: "memory");
  __syncthreads();
  if (threadIdx.x == 0) {
    unsigned* bar = bar_in;
    __builtin_amdgcn_s_waitcnt(0);
    unsigned nloc = b.st[0], nx = b.st[1];
    if (nloc == 0u) { xcd_barrier_complete(bar, b.x, nloc, nx); b.st[0] = nloc; b.st[1] = nx; }
    const unsigned old = xb_add(&bar[XB_XSUB(b.x)], 1u);
    const unsigned gen = old / nloc;
    if (old + 1u == (gen + 1u) * nloc) {
      __builtin_amdgcn_fence(__ATOMIC_RELEASE, "agent");
      asm volatile("s_waitcnt vmcnt(0)" ::: "memory");
      const unsigned og = xb_add(&bar[XB_TOP], 1u);
      const unsigned tg = og / nx;
      if (og + 1u == (tg + 1u) * nx) xb_add(&bar[XB_TOPGEN], 1u);
      else XB_SPIN(xb_ld(&bar[XB_TOPGEN]) == tg, bar);
      __builtin_amdgcn_fence(__ATOMIC_ACQUIRE, "agent");
      xb_add(&bar[XB_XGEN(b.x)], 1u);
      asm volatile("s_waitcnt vmcnt(0)" ::: "memory");
    } else {
      XB_SPIN(xb_ld(&bar[XB_XGEN(b.x)]) == gen, bar);
      __builtin_amdgcn_fence(__ATOMIC_ACQUIRE, "agent");
      asm volatile("s_waitcnt vmcnt(0)" ::: "memory");
    }
  }
  __syncthreads();
}

struct CvtTile { const float* src; bf16_t* dst; const float* rs; const float* cs; int K, N, blk, bs, off, kt, nt; };
constexpr int CVT_T0 = 32 * 52, CVT_T1 = CVT_T0 + 16, CVT_T2 = CVT_T1 + 3 * 128, CVT_T3 = CVT_T2 + 256, CVT_T4 = CVT_T3 + 2 * 704, CVT_TOTAL = CVT_T4 + 704;
DI CvtTile cvt_tile(KParams p, int l, int t) {
  char* ws = p->ws; CvtTile c; c.rs = nullptr; c.cs = nullptr; c.bs = 0; c.off = 0;
  int tt;
  if (t < CVT_T0) { tt = t; c.src = p->w_in + (size_t)l * DM * INW; c.dst = (bf16_t*)(ws + OFF_WIN); c.K = DM; c.N = INW; c.blk = INW; c.rs = p->norm_mix + l * DM; }
  else if (t < CVT_T1) { const int g = (t - CVT_T0) >> 2; tt = (t - CVT_T0) & 3; c.src = p->w_pool + ((size_t)l * 4 + g) * 65536; c.dst = (bf16_t*)(ws + OFF_WPOOL) + g * 65536; c.K = 256; c.N = 256; c.blk = 256; c.cs = p->pool_scale + l * 1024 + g * 256; }
  else if (t < CVT_T2) { const int b = (t - CVT_T1) >> 7; tt = (t - CVT_T1) & 127; const float* wa = p->w_br_a; const float* wb = p->w_br_b; const float* wc3 = p->w_br_c; asm volatile("" : "+s"(wa), "+s"(wb), "+s"(wc3)); c.src = (b == 0 ? wa : b == 1 ? wb : wc3) + (size_t)l * 1024 * DM; c.dst = (bf16_t*)(ws + OFF_WBR + b * SZ_WBR1); c.K = 1024; c.N = DM; c.blk = DM; }
  else if (t < CVT_T3) { tt = t - CVT_T2; c.src = p->w_out + (size_t)l * DM * DM; c.dst = (bf16_t*)(ws + OFF_WOUT); c.K = DM; c.N = DM; c.blk = DM; }
  else if (t < CVT_T4) { const int u = (t - CVT_T3) >= 704; tt = (t - CVT_T3) - u * 704; const float* wg = p->w_gate; const float* wu = p->w_up; asm volatile("" : "+s"(wg), "+s"(wu)); c.src = (u ? wu : wg) + (size_t)l * DM * DFF; c.dst = (bf16_t*)(ws + OFF_WGU); c.K = DM; c.N = DFF; c.blk = 128; c.bs = 256; c.off = u * 128; c.rs = p->norm_ffn + l * DM; }
  else { tt = t - CVT_T4; c.src = p->w_down + (size_t)l * DFF * DM; c.dst = (bf16_t*)(ws + OFF_WDOWN); c.K = DFF; c.N = DM; c.blk = DM; }
  const int ntn = c.N >> 8; c.kt = tt / ntn; c.nt = tt - c.kt * ntn;
  return c;
}

DI void convert_layer(KParams p, int l, char* shm) {
  float* tile = (float*)shm;
  const int tid = opaque_tid(), lane = tid & 63, w = tid >> 6;
  f32x4 v[8];
#define CVT_LOAD(tt) do { const CvtTile _c = cvt_tile(p, l, (tt)); \
    _Pragma("unroll") for (int i = 0; i < 8; ++i) { const int idx = tid + 512 * i, k = idx >> 6, n4 = idx & 63; v[i] = *(const f32x4*)(_c.src + (size_t)(_c.kt * 64 + k) * _c.N + _c.nt * 256 + 4 * n4); } } while (0)
  if ((int)blockIdx.x < CVT_TOTAL) CVT_LOAD(blockIdx.x);
  for (int t = blockIdx.x; t < CVT_TOTAL; t += gridDim.x) {
    const CvtTile c = cvt_tile(p, l, t);
    const int k0 = c.kt * 64, n0 = c.nt * 256;
    __syncthreads();
#pragma unroll
    for (int i = 0; i < 8; ++i) { const int idx = tid + 512 * i, k = idx >> 6, n4 = idx & 63; *(f32x4*)(tile + k * 256 + 4 * (n4 ^ ((k >> 3) & 7))) = v[i]; }
    __syncthreads();
    if (t + (int)gridDim.x < CVT_TOTAL) CVT_LOAD(t + gridDim.x);
    const int kc = lane >> 3;
    f32x4 g0 = {1.f, 1.f, 1.f, 1.f}, g1 = g0;
    if (c.rs) { g0 = *(const f32x4*)(c.rs + k0 + kc * 8); g1 = *(const f32x4*)(c.rs + k0 + kc * 8 + 4); }
#pragma unroll
    for (int pass = 0; pass < 4; ++pass) {
      const int n = 32 * w + 8 * pass + (lane & 7);
      float f[8];
#pragma unroll
      for (int j = 0; j < 8; ++j) f[j] = tile[(kc * 8 + j) * 256 + 4 * ((n >> 2) ^ kc) + (n & 3)];
      const int ng = n0 + n;
      const float cc = c.cs ? c.cs[ng] : 1.f;
      u32x4 o;
      o[0] = pk_bf16(f[0] * g0[0] * cc, f[1] * g0[1] * cc); o[1] = pk_bf16(f[2] * g0[2] * cc, f[3] * g0[3] * cc);
      o[2] = pk_bf16(f[4] * g1[0] * cc, f[5] * g1[1] * cc); o[3] = pk_bf16(f[6] * g1[2] * cc, f[7] * g1[3] * cc);
      const int q = ng / c.blk, dr0 = q * c.bs + c.off + (ng - q * c.blk);
      const int c32 = dr0 & 31, drow = (dr0 & ~31) + 16 * ((c32 >> 2) & 1) + 4 * (c32 >> 3) + (c32 & 3);
      *(u32x4*)(c.dst + (size_t)drow * c.K + k0 + kc * 8) = o;
    }
  }
#undef CVT_LOAD
}

DI void x_prep(KParams p) {
  const int tid = opaque_tid(), lane = tid & 63, w = tid >> 6;
  bf16_t* xb = (bf16_t*)(p->ws + OFF_XB); float* ssq = (float*)(p->ws + OFF_SSQ);
  const float* x = p->x;
  for (int row = blockIdx.x * 8 + w; row < MTOK; row += gridDim.x * 16) {
    const int row2 = row + gridDim.x * 8;
    const bool has2 = row2 < MTOK;
    f32x4 va[8], vb[8];
#pragma unroll
    for (int i = 0; i < 8; ++i) { const int c = (i * 64 + lane) * 4; va[i] = *(const f32x4*)(x + (size_t)row * DM + c); vb[i] = has2 ? *(const f32x4*)(x + (size_t)row2 * DM + c) : (f32x4){0.f, 0.f, 0.f, 0.f}; }
    float s0 = 0.f, s1 = 0.f;
#pragma unroll
    for (int i = 0; i < 8; ++i) {
      const int c = (i * 64 + lane) * 4;
      s0 += va[i][0] * va[i][0] + va[i][1] * va[i][1] + va[i][2] * va[i][2] + va[i][3] * va[i][3];
      s1 += vb[i][0] * vb[i][0] + vb[i][1] * vb[i][1] + vb[i][2] * vb[i][2] + vb[i][3] * vb[i][3];
      u32x2 o; o[0] = pk_bf16(va[i][0], va[i][1]); o[1] = pk_bf16(va[i][2], va[i][3]);
      *(u32x2*)(xb + (size_t)row * XB_LD + c) = o;
      if (has2) { u32x2 o2; o2[0] = pk_bf16(vb[i][0], vb[i][1]); o2[1] = pk_bf16(vb[i][2], vb[i][3]); *(u32x2*)(xb + (size_t)row2 * XB_LD + c) = o2; }
    }
    s0 += __shfl_xor(s0, 32); s1 += __shfl_xor(s1, 32);
    if (lane < 32) { ssq[(size_t)row * 32 + lane] = s0; if (has2) ssq[(size_t)row2 * 32 + lane] = s1; }
  }
}

DI void final_norm(KParams p) {
  const int tid = opaque_tid(), lane = tid & 63, w = tid >> 6;
  const float* ssq = (const float*)(p->ws + OFF_SSQ);
  const bf16_t* xb = (const bf16_t*)(p->ws + OFF_XB);
  float* out = p->out;
  f32x4 g[4][2];
#pragma unroll
  for (int i = 0; i < 4; ++i) { g[i][0] = *(const f32x4*)(p->norm_final + (i * 64 + lane) * 8); g[i][1] = *(const f32x4*)(p->norm_final + (i * 64 + lane) * 8 + 4); }
  for (int row = blockIdx.x * 8 + w; row < MTOK; row += gridDim.x * 16) {
    const int row2 = row + gridDim.x * 8;
    const bool has2 = row2 < MTOK;
    float s0 = (lane < 32) ? ssq[(size_t)row * 32 + lane] : 0.f, s1 = (lane < 32 && has2) ? ssq[(size_t)row2 * 32 + lane] : 0.f;
    u32x4 va[4], vb[4];
#pragma unroll
    for (int i = 0; i < 4; ++i) { const int c = (i * 64 + lane) * 8; va[i] = *(const u32x4*)(xb + (size_t)row * XB_LD + c); vb[i] = has2 ? *(const u32x4*)(xb + (size_t)row2 * XB_LD + c) : (u32x4){0u, 0u, 0u, 0u}; }
#pragma unroll
    for (int o = 32; o >= 1; o >>= 1) { s0 += __shfl_xor(s0, o); s1 += __shfl_xor(s1, o); }
    const float r0 = rsqrtf(s0 * (1.f / DM) + 1e-6f), r1 = rsqrtf(s1 * (1.f / DM) + 1e-6f);
#pragma unroll
    for (int i = 0; i < 4; ++i) {
      const int c = (i * 64 + lane) * 8;
      f32x4 a, b;
      a[0] = bflo(va[i][0]) * r0 * g[i][0][0]; a[1] = bfhi(va[i][0]) * r0 * g[i][0][1]; a[2] = bflo(va[i][1]) * r0 * g[i][0][2]; a[3] = bfhi(va[i][1]) * r0 * g[i][0][3];
      b[0] = bflo(va[i][2]) * r0 * g[i][1][0]; b[1] = bfhi(va[i][2]) * r0 * g[i][1][1]; b[2] = bflo(va[i][3]) * r0 * g[i][1][2]; b[3] = bfhi(va[i][3]) * r0 * g[i][1][3];
      __builtin_nontemporal_store(a, (f32x4*)(out + (size_t)row * DM + c)); __builtin_nontemporal_store(b, (f32x4*)(out + (size_t)row * DM + c + 4));
      if (has2) {
        a[0] = bflo(vb[i][0]) * r1 * g[i][0][0]; a[1] = bfhi(vb[i][0]) * r1 * g[i][0][1]; a[2] = bflo(vb[i][1]) * r1 * g[i][0][2]; a[3] = bfhi(vb[i][1]) * r1 * g[i][0][3];
        b[0] = bflo(vb[i][2]) * r1 * g[i][1][0]; b[1] = bfhi(vb[i][2]) * r1 * g[i][1][1]; b[2] = bflo(vb[i][3]) * r1 * g[i][1][2]; b[3] = bfhi(vb[i][3]) * r1 * g[i][1][3];
        __builtin_nontemporal_store(a, (f32x4*)(out + (size_t)row2 * DM + c)); __builtin_nontemporal_store(b, (f32x4*)(out + (size_t)row2 * DM + c + 4));
      }
    }
  }
}

DI void pool_tile(KParams p, int brow, int g) {
  const bf16_t* proj = (const bf16_t*)(p->ws + OFF_PROJ);
  bf16_t* P = (bf16_t*)(p->ws + OFF_P);
  const int tid = opaque_tid();
  const int win = 2 << g;
  for (int it = 0; it < 16; it += 2) {
    const int idx0 = it * 512 + tid, idx1 = idx0 + 512, c = g * 256 + (tid & 31) * 8;
    const int tok0 = brow + (idx0 >> 5), tok1 = brow + (idx1 >> 5);
    const int cnt0 = min(win, (tok0 & (SEQ - 1)) + 1), cnt1 = min(win, (tok1 & (SEQ - 1)) + 1);
    const bf16_t* up0 = proj + (size_t)tok0 * PROJ_LD + 3072 + c;
    const bf16_t* up1 = proj + (size_t)tok1 * PROJ_LD + 3072 + c;
    u32x4 ua[16], ub[16];
#pragma unroll
    for (int j = 0; j < 16; ++j) {
      ua[j] = (j < cnt0) ? *(const u32x4*)(up0 - (size_t)j * PROJ_LD) : (u32x4){0u, 0u, 0u, 0u};
      ub[j] = (j < cnt1) ? *(const u32x4*)(up1 - (size_t)j * PROJ_LD) : (u32x4){0u, 0u, 0u, 0u};
    }
    float a0[8] = {0.f, 0.f, 0.f, 0.f, 0.f, 0.f, 0.f, 0.f}, a1[8] = {0.f, 0.f, 0.f, 0.f, 0.f, 0.f, 0.f, 0.f};
#pragma unroll
    for (int j = 0; j < 16; ++j) {
#pragma unroll
      for (int e = 0; e < 4; ++e) { a0[2 * e] += bflo(ua[j][e]); a0[2 * e + 1] += bfhi(ua[j][e]); a1[2 * e] += bflo(ub[j][e]); a1[2 * e + 1] += bfhi(ub[j][e]); }
    }
    const float i0 = 1.f / (float)cnt0, i1 = 1.f / (float)cnt1;
    u32x4 o0, o1;
#pragma unroll
    for (int e = 0; e < 4; ++e) {
      o0[e] = pk_bf16(a0[2 * e] * i0 - bflo(ua[0][e]), a0[2 * e + 1] * i0 - bfhi(ua[0][e]));
      o1[e] = pk_bf16(a1[2 * e] * i1 - bflo(ub[0][e]), a1[2 * e + 1] * i1 - bfhi(ub[0][e]));
    }
    *(u32x4*)(P + (size_t)tok0 * P_LD + c) = o0;
    *(u32x4*)(P + (size_t)tok1 * P_LD + c) = o1;
  }
}

constexpr int BK = 64, HALF = 128, HT = HALF * BK;
constexpr int GEMM_LDS = 8 * HT * 2;
constexpr int RS_OFF = GEMM_LDS;
enum { EPI_IN = 0, EPI_POOL = 1, EPI_BR = 2, EPI_RES = 3, EPI_FFN1 = 4 };

DI int lds_byte(int r, int c) { const int st = (r >> 4) * 2 + (c >> 5), rr = r & 15, cc = c & 31, ob = rr * 64 + cc * 2; return st * 1024 + (ob ^ (((ob >> 9) & 1) << 5)); }
DI void stage_rc(int b, int& R, int& C) { const int st = b / 1024, sb = b % 1024, swz = sb ^ (((sb >> 9) & 1) << 5); R = (st >> 1) * 16 + swz / 64; C = (st & 1) * 32 + (swz % 64) / 2; }

DI bool tile_order(int L, int nM, int nN, int& pm, int& pn) {
  const int nwg = nM * nN; if (L >= nwg) return false;
  int wgid = L; { const int q = nwg / 8, r = nwg % 8, xcd = wgid % 8, off = wgid / 8; wgid = (xcd < r ? xcd * (q + 1) : r * (q + 1) + (xcd - r) * q) + off; }
  const int nig = 8 * nN, gid = wgid / nig, fm = gid * 8, gsz = (nM - fm) < 8 ? (nM - fm) : 8;
  pm = fm + ((wgid % nig) % gsz); pn = (wgid % nig) / gsz; return true;
}

DI void gemm_phase(KParams p, const bf16_t* __restrict__ A, int lda, const bf16_t* __restrict__ Bt, int ldb, int K, int nN, int kind,
                   int nsub, size_t asub, size_t bsub, int acs, int oc0, int ocs, const float* hin, char* shmc) {
  LAS unsigned char* lds = (LAS unsigned char*)shmc;
  const int tid = opaque_tid();
  const int wid = __builtin_amdgcn_readfirstlane(tid >> 6), lane = tid & 63, wr = wid >> 2, wc = wid & 3, fr = lane & 15, fq = lane >> 4;
  unsigned voffA[2], voffB[2];
#pragma unroll
  for (int i = 0; i < 2; ++i) { int R, C; stage_rc(tid * 16 + i * 8192, R, C); voffA[i] = (unsigned)(R * lda + C) * 2u; voffB[i] = (unsigned)(R * ldb + C) * 2u; }
  const unsigned ldsw = (unsigned)wid * 1024u;
  const int aoff = lds_byte(wr * 64 + fr, fq * 8), boff = lds_byte(wc * 32 + fr, fq * 8);
  const size_t hA = (size_t)HALF * lda * 2, hB = (size_t)HALF * ldb * 2;
#define SA(b, h) (((b) * 2 + (h)) * (HT * 2))
#define SB(b, h) ((4 + (b) * 2 + (h)) * (HT * 2))
#define STAGE(bufoff, gbase, voff) do { const char* _gb = uni_ptr(gbase); _Pragma("unroll") for (int _i = 0; _i < 2; ++_i) { unsigned _vo = (voff)[_i]; asm volatile("" : "+v"(_vo)); \
    __builtin_amdgcn_global_load_lds((const unsigned*)(_gb + _vo), (LAS unsigned*)(lds + (bufoff) + ldsw + _i * 8192), 16, 0, 0); } } while (0)
#define STA(P, hf, kt) STAGE(P, cA + (hf) * hA + (size_t)(kt) * (BK * 2), voffA)
#define STB(P, hf, kt) STAGE(P, cB + (hf) * hB + (size_t)(kt) * (BK * 2), voffB)
#define ISSUE_PROLOGUE() do { STB(SB(0, 0), 0, 0); STA(SA(0, 0), 0, 0); STB(SB(0, 1), 1, 0); STA(SA(0, 1), 1, 0); \
    STB(SB(1, 0), 0, 1); STA(SA(1, 0), 0, 1); STB(SB(1, 1), 1, 1); } while (0)
#define LDA(dst, b, h) do { _Pragma("unroll") for (int m = 0; m < 4; ++m) _Pragma("unroll") for (int k = 0; k < 2; ++k) dst[m][k] = *(const LAS bf16x8*)(lds + SA(b, h) + aoff + m * 2048 + k * 1024); } while (0)
#define LDB(dst, b, h) do { _Pragma("unroll") for (int n = 0; n < 2; ++n) _Pragma("unroll") for (int k = 0; k < 2; ++k) dst[n][k] = *(const LAS bf16x8*)(lds + SB(b, h) + boff + n * 2048 + k * 1024); } while (0)
#define MMA(ai, bj, Af, Bf) do { __builtin_amdgcn_s_setprio(1); \
    _Pragma("unroll") for (int m = 0; m < 4; ++m) _Pragma("unroll") for (int n = 0; n < 2; ++n) _Pragma("unroll") for (int k = 0; k < 2; ++k) \
      acc[ai][bj][m][n] = __builtin_amdgcn_mfma_f32_16x16x32_bf16(Bf[n][k], Af[m][k], acc[ai][bj][m][n], 0, 0, 0); \
    __builtin_amdgcn_s_setprio(0); } while (0)
#define WAIT_V(n) asm volatile("s_waitcnt vmcnt(" #n ")" ::: "memory")
#define WAIT_L(n) asm volatile("s_waitcnt lgkmcnt(" #n ")" ::: "memory")
#define BAR __builtin_amdgcn_s_barrier()
#define SCHED __builtin_amdgcn_sched_barrier(0)

  int pm, pn, sub = 0, rnd = 0, rs_brow = -1;
  if (!tile_order(blockIdx.x, 64, nN, pm, pn)) return;
  const char* cA = (const char*)(A + pn * acs) + (size_t)pm * 256 * lda * 2;
  const char* cB = (const char*)Bt + (size_t)pn * 256 * ldb * 2;
  if (kind == EPI_POOL) {
    int qm, qn;
    for (int r2 = 0; tile_order(r2 * gridDim.x + blockIdx.x, 64, nN, qm, qn); ++r2) pool_tile(p, qm * 256, qn);
    asm volatile("s_waitcnt vmcnt(0)" ::: "memory");
  }
  __syncthreads();
  ISSUE_PROLOGUE();
  const int nt = K / BK;
  bool have = true;
  while (have) {
    const int brow = pm * 256, ocol = oc0 + pn * ocs, aux = sub;
    float* rsl = (float*)(shmc + RS_OFF);
    if ((kind == EPI_IN || kind == EPI_FFN1) && brow != rs_brow) {
      rs_brow = brow;
      __syncthreads();
      if (tid < 256) {
        const float* sp = (const float*)(p->ws + OFF_SSQ) + (size_t)(brow + tid) * 32;
        float s = 0.f;
#pragma unroll
        for (int i = 0; i < 8; ++i) { const f32x4 v = *(const f32x4*)(sp + 4 * i); s += (v[0] + v[1]) + (v[2] + v[3]); }
        rsl[tid] = rsqrtf(s * (1.f / DM) + 1e-6f);
      }
    }
    f32x4 acc[2][2][4][2];
#pragma unroll
    for (int a = 0; a < 2; ++a)
#pragma unroll
      for (int b = 0; b < 2; ++b)
#pragma unroll
        for (int m = 0; m < 4; ++m)
#pragma unroll
          for (int n = 0; n < 2; ++n) acc[a][b][m][n] = (f32x4){0.f, 0.f, 0.f, 0.f};
    bf16x8 At[4][2], B0[2][2], B1[2][2];
    if (wr == 1) BAR;
    WAIT_V(10); BAR;
    WAIT_V(6); BAR;
    for (int t = 0; t < nt - 2; t += 2) {
      LDB(B0, 0, 0); SCHED; LDA(At, 0, 0); STA(SA(1, 1), 1, t + 1);
      WAIT_L(8); BAR; WAIT_L(0); MMA(0, 0, At, B0); BAR; SCHED;
      LDB(B1, 0, 1); STB(SB(0, 0), 0, t + 2);
      BAR; WAIT_L(0); MMA(0, 1, At, B1); BAR;
      LDA(At, 0, 1); STA(SA(0, 0), 0, t + 2);
      BAR; WAIT_L(0); MMA(1, 0, At, B0); BAR; SCHED;
      STB(SB(0, 1), 1, t + 2);
      WAIT_V(6); BAR; MMA(1, 1, At, B1); BAR;
      LDB(B0, 1, 0); SCHED; LDA(At, 1, 0); STA(SA(0, 1), 1, t + 2);
      WAIT_L(8); BAR; WAIT_L(0); MMA(0, 0, At, B0); BAR; SCHED;
      LDB(B1, 1, 1); STB(SB(1, 0), 0, t + 3);
      BAR; WAIT_L(0); MMA(0, 1, At, B1); BAR;
      LDA(At, 1, 1); STA(SA(1, 0), 0, t + 3);
      BAR; WAIT_L(0); MMA(1, 0, At, B0); BAR; SCHED;
      STB(SB(1, 1), 1, t + 3);
      WAIT_V(6); BAR; MMA(1, 1, At, B1); BAR;
    }
    { LDB(B0, 0, 0); LDA(At, 0, 0); STA(SA(1, 1), 1, nt - 1);
      BAR; WAIT_L(0); MMA(0, 0, At, B0); BAR;
      LDB(B1, 0, 1); BAR; WAIT_L(0); MMA(0, 1, At, B1); BAR;
      LDA(At, 0, 1); WAIT_V(4); BAR; WAIT_L(0); MMA(1, 0, At, B0); MMA(1, 1, At, B1); BAR; }
    { LDB(B0, 1, 0); LDA(At, 1, 0); WAIT_V(2); BAR; WAIT_L(0); MMA(0, 0, At, B0); BAR;
      LDB(B1, 1, 1); WAIT_V(0); BAR; WAIT_L(0); MMA(0, 1, At, B1); BAR;
      LDA(At, 1, 1); BAR; WAIT_L(0); MMA(1, 0, At, B0); MMA(1, 1, At, B1); BAR; }
    if (wr == 0) BAR;
    {
      int pm2 = pm, pn2 = pn, sub2 = sub + 1;
      if (sub2 == nsub) { sub2 = 0; ++rnd; have = tile_order(rnd * gridDim.x + blockIdx.x, 64, nN, pm2, pn2); }
      if (have) {
        cA = (const char*)(A + sub2 * asub + pn2 * acs) + (size_t)pm2 * 256 * lda * 2;
        cB = (const char*)(Bt + sub2 * bsub) + (size_t)pn2 * 256 * ldb * 2;
        ISSUE_PROLOGUE();
      }
      pm = pm2; pn = pn2; sub = sub2;
    }
    char* ws = p->ws;
    int cl = wc * 32 + 8 * fq; asm volatile("" : "+v"(cl));
    int fr_e = fr; asm volatile("" : "+v"(fr_e));
    if (kind == EPI_IN) {
      const bool isgate = ocol >= PROJ_W;
      bf16_t* obase = isgate ? (bf16_t*)(ws + OFF_GATES) + (ocol - PROJ_W) : (bf16_t*)(ws + OFF_PROJ) + ocol;
      const int old = isgate ? GATE_LD : PROJ_LD;
#pragma unroll
      for (int ai = 0; ai < 2; ++ai)
#pragma unroll
        for (int m = 0; m < 4; ++m) {
          const int rl = ai * HALF + wr * 64 + m * 16 + fr_e;
          const float rs = rsl[rl];
          bf16_t* rowp = obase + (size_t)(brow + rl) * old + cl;
#pragma unroll
          for (int bj = 0; bj < 2; ++bj) {
            f32x4 v0 = acc[ai][bj][m][0] * rs, v1 = acc[ai][bj][m][1] * rs;
            if (isgate) {
#pragma unroll
              for (int j = 0; j < 4; ++j) { v0[j] = __builtin_amdgcn_rcpf(1.f + fexp2(-LOG2E * v0[j])); v1[j] = __builtin_amdgcn_rcpf(1.f + fexp2(-LOG2E * v1[j])); }
            }
            u32x4 o; o[0] = pk_bf16(v0[0], v0[1]); o[1] = pk_bf16(v0[2], v0[3]); o[2] = pk_bf16(v1[0], v1[1]); o[3] = pk_bf16(v1[2], v1[3]);
            *(u32x4*)(rowp + bj * HALF) = o;
          }
        }
      if (ocol >= 1024 && ocol < 2048) {
        float* kb2 = (float*)(ws + OFF_KBAR) + ((size_t)(brow >> 8) * 2 + wr) * 1024 + (ocol - 1024) + cl;
#pragma unroll
        for (int bj = 0; bj < 2; ++bj)
#pragma unroll
          for (int n = 0; n < 2; ++n) {
            f32x4 s = {0.f, 0.f, 0.f, 0.f};
#pragma unroll
            for (int ai = 0; ai < 2; ++ai)
#pragma unroll
              for (int m = 0; m < 4; ++m) s += acc[ai][bj][m][n] * rsl[ai * HALF + wr * 64 + m * 16 + fr_e];
#pragma unroll
            for (int j = 0; j < 4; ++j) { float t = s[j]; t += __shfl_xor(t, 1); t += __shfl_xor(t, 2); t += __shfl_xor(t, 4); t += __shfl_xor(t, 8); s[j] = t; }
            if (fr_e == 0) *(f32x4*)(kb2 + bj * HALF + 4 * n) = s;
          }
      }
    } else if (kind == EPI_POOL) {
      bf16_t* obase = (bf16_t*)(ws + OFF_Y) + ocol;
#pragma unroll
      for (int ai = 0; ai < 2; ++ai)
#pragma unroll
        for (int m = 0; m < 4; ++m) {
          const int rl = ai * HALF + wr * 64 + m * 16 + fr_e;
          bf16_t* rowp = obase + (size_t)(brow + rl) * Y_LD + cl;
#pragma unroll
          for (int bj = 0; bj < 2; ++bj) {
            const f32x4 v0 = acc[ai][bj][m][0], v1 = acc[ai][bj][m][1];
            u32x4 o; o[0] = pk_bf16(v0[0], v0[1]); o[1] = pk_bf16(v0[2], v0[3]); o[2] = pk_bf16(v1[0], v1[1]); o[3] = pk_bf16(v1[2], v1[3]);
            *(u32x4*)(rowp + bj * HALF) = o;
          }
        }
    } else if (kind == EPI_BR) {
      const bf16_t* gbase = (const bf16_t*)(ws + OFF_GATES) + aux * DM + ocol;
      bf16_t* mbase = (bf16_t*)(ws + OFF_PROJ) + ocol;
#pragma unroll
      for (int ai = 0; ai < 2; ++ai) {
        u32x4 gg[4][2], mm[4][2];
#pragma unroll
        for (int m = 0; m < 4; ++m) {
          const int rl = ai * HALF + wr * 64 + m * 16 + fr_e;
          const bf16_t* grow = gbase + (size_t)(brow + rl) * GATE_LD + cl;
          const bf16_t* mrow = mbase + (size_t)(brow + rl) * M_LD + cl;
#pragma unroll
          for (int bj = 0; bj < 2; ++bj) {
            gg[m][bj] = *(const u32x4*)(grow + bj * HALF);
            mm[m][bj] = (aux != 0) ? *(const u32x4*)(mrow + bj * HALF) : (u32x4){0u, 0u, 0u, 0u};
          }
        }
#pragma unroll
        for (int m = 0; m < 4; ++m) {
          const int rl = ai * HALF + wr * 64 + m * 16 + fr_e;
          bf16_t* mrow = mbase + (size_t)(brow + rl) * M_LD + cl;
#pragma unroll
          for (int bj = 0; bj < 2; ++bj) {
            const u32x4 g = gg[m][bj], mo = mm[m][bj];
            f32x4 v0 = acc[ai][bj][m][0], v1 = acc[ai][bj][m][1];
            v0[0] = v0[0] * bflo(g[0]) + bflo(mo[0]); v0[1] = v0[1] * bfhi(g[0]) + bfhi(mo[0]); v0[2] = v0[2] * bflo(g[1]) + bflo(mo[1]); v0[3] = v0[3] * bfhi(g[1]) + bfhi(mo[1]);
            v1[0] = v1[0] * bflo(g[2]) + bflo(mo[2]); v1[1] = v1[1] * bfhi(g[2]) + bfhi(mo[2]); v1[2] = v1[2] * bflo(g[3]) + bflo(mo[3]); v1[3] = v1[3] * bfhi(g[3]) + bfhi(mo[3]);
            u32x4 o; o[0] = pk_bf16(v0[0], v0[1]); o[1] = pk_bf16(v0[2], v0[3]); o[2] = pk_bf16(v1[0], v1[1]); o[3] = pk_bf16(v1[2], v1[3]);
            *(u32x4*)(mrow + bj * HALF) = o;
          }
        }
      }
    } else if (kind == EPI_RES) {
      bf16_t* xb = (bf16_t*)(ws + OFF_XB) + ocol;
      float* ssq = (float*)(ws + OFF_SSQ);
      const int pslot = (ocol >> 8) * 4 + wc;
#pragma unroll
      for (int ai = 0; ai < 2; ++ai) {
        u32x4 hh[4][2];
#pragma unroll
        for (int m = 0; m < 4; ++m) {
          const int rl = ai * HALF + wr * 64 + m * 16 + fr_e;
          const bf16_t* xr = xb + (size_t)(brow + rl) * XB_LD + cl;
#pragma unroll
          for (int bj = 0; bj < 2; ++bj) hh[m][bj] = *(const u32x4*)(xr + bj * HALF);
        }
#pragma unroll
        for (int m = 0; m < 4; ++m) {
          const int rl = ai * HALF + wr * 64 + m * 16 + fr_e;
          bf16_t* xr = xb + (size_t)(brow + rl) * XB_LD + cl;
          float s = 0.f;
#pragma unroll
          for (int bj = 0; bj < 2; ++bj) {
            const u32x4 h = hh[m][bj];
            f32x4 v0 = acc[ai][bj][m][0], v1 = acc[ai][bj][m][1];
            v0[0] += bflo(h[0]); v0[1] += bfhi(h[0]); v0[2] += bflo(h[1]); v0[3] += bfhi(h[1]);
            v1[0] += bflo(h[2]); v1[1] += bfhi(h[2]); v1[2] += bflo(h[3]); v1[3] += bfhi(h[3]);
            s += v0[0] * v0[0] + v0[1] * v0[1] + v0[2] * v0[2] + v0[3] * v0[3] + v1[0] * v1[0] + v1[1] * v1[1] + v1[2] * v1[2] + v1[3] * v1[3];
            u32x4 o; o[0] = pk_bf16(v0[0], v0[1]); o[1] = pk_bf16(v0[2], v0[3]); o[2] = pk_bf16(v1[0], v1[1]); o[3] = pk_bf16(v1[2], v1[3]);
            *(u32x4*)(xr + bj * HALF) = o;
          }
          s += __shfl_xor(s, 16); s += __shfl_xor(s, 32);
          if (fq == 0) ssq[(size_t)(brow + rl) * 32 + pslot] = s;
        }
      }
    } else {
      bf16_t* abase = (bf16_t*)(ws + OFF_PROJ) + ocol;
#pragma unroll
      for (int ai = 0; ai < 2; ++ai)
#pragma unroll
        for (int m = 0; m < 4; ++m) {
          const int rl = ai * HALF + wr * 64 + m * 16 + fr_e;
          const float rs = rsl[rl];
          bf16_t* rowp = abase + (size_t)(brow + rl) * ACT_LD + cl;
          f32x4 v[2];
#pragma unroll
          for (int n = 0; n < 2; ++n) {
            const f32x4 g = acc[ai][0][m][n] * rs, u = acc[ai][1][m][n] * rs;
#pragma unroll
            for (int j = 0; j < 4; ++j) v[n][j] = g[j] * __builtin_amdgcn_rcpf(1.f + fexp2(-LOG2E * g[j])) * u[j];
          }
          u32x4 o; o[0] = pk_bf16(v[0][0], v[0][1]); o[1] = pk_bf16(v[0][2], v[0][3]); o[2] = pk_bf16(v[1][0], v[1][1]); o[3] = pk_bf16(v[1][2], v[1][3]);
          *(u32x4*)rowp = o;
        }
    }
  }
}

DI void branch_phase(KParams p, char* shmc) {
  LAS unsigned char* lds = (LAS unsigned char*)shmc;
  const int tid = opaque_tid();
  const int wid = __builtin_amdgcn_readfirstlane(tid >> 6), lane = tid & 63, wr = wid >> 2, wc = wid & 3, fr = lane & 15, fq = lane >> 4;
  const int lda = Y_LD, ldb = 1024;
  unsigned voffA[2], voffB[2];
#pragma unroll
  for (int i = 0; i < 2; ++i) { int R, C; stage_rc(tid * 16 + i * 8192, R, C); voffA[i] = (unsigned)(R * lda + C) * 2u; voffB[i] = (unsigned)(R * ldb + C) * 2u; }
  const unsigned ldsw = (unsigned)wid * 1024u;
  const int aoff = lds_byte(wr * 64 + fr, fq * 8), boff = lds_byte(wc * 32 + fr, fq * 8);
  const size_t hA = (size_t)HALF * lda * 2, hB = (size_t)HALF * ldb * 2;
  char* ws = p->ws;
  const bf16_t* Y = (const bf16_t*)(ws + OFF_Y); const bf16_t* W = (const bf16_t*)(ws + OFF_WBR);
  int pm, pn, rnd = 0;
  if (!tile_order(blockIdx.x, 64, 8, pm, pn)) return;
  const char* cA = (const char*)Y + (size_t)pm * 256 * lda * 2;
  const char* cB = (const char*)W + (size_t)pn * 256 * ldb * 2;
  __syncthreads();
  ISSUE_PROLOGUE();
  const int nt = 16;
  bool have = true;
  while (have) {
    const int brow = pm * 256, ocol = pn * 256;
    int pm2 = pm, pn2 = pn;
    f32x4 acc[2][2][4][2];
#pragma unroll
    for (int a = 0; a < 2; ++a)
#pragma unroll
      for (int b = 0; b < 2; ++b)
#pragma unroll
        for (int m = 0; m < 4; ++m)
#pragma unroll
          for (int n = 0; n < 2; ++n) acc[a][b][m][n] = (f32x4){0.f, 0.f, 0.f, 0.f};
#pragma unroll 1
    for (int br = 0; br < 3; ++br) {
      bf16x8 At[4][2], B0[2][2], B1[2][2];
      if (wr == 1) BAR;
      WAIT_V(10); BAR;
      WAIT_V(6); BAR;
      for (int t = 0; t < nt - 2; t += 2) {
        LDB(B0, 0, 0); SCHED; LDA(At, 0, 0); STA(SA(1, 1), 1, t + 1);
        WAIT_L(8); BAR; WAIT_L(0); MMA(0, 0, At, B0); BAR; SCHED;
        LDB(B1, 0, 1); STB(SB(0, 0), 0, t + 2);
        BAR; WAIT_L(0); MMA(0, 1, At, B1); BAR;
        LDA(At, 0, 1); STA(SA(0, 0), 0, t + 2);
        BAR; WAIT_L(0); MMA(1, 0, At, B0); BAR; SCHED;
        STB(SB(0, 1), 1, t + 2);
        WAIT_V(6); BAR; MMA(1, 1, At, B1); BAR;
        LDB(B0, 1, 0); SCHED; LDA(At, 1, 0); STA(SA(0, 1), 1, t + 2);
        WAIT_L(8); BAR; WAIT_L(0); MMA(0, 0, At, B0); BAR; SCHED;
        LDB(B1, 1, 1); STB(SB(1, 0), 0, t + 3);
        BAR; WAIT_L(0); MMA(0, 1, At, B1); BAR;
        LDA(At, 1, 1); STA(SA(1, 0), 0, t + 3);
        BAR; WAIT_L(0); MMA(1, 0, At, B0); BAR; SCHED;
        STB(SB(1, 1), 1, t + 3);
        WAIT_V(6); BAR; MMA(1, 1, At, B1); BAR;
      }
      { LDB(B0, 0, 0); LDA(At, 0, 0); STA(SA(1, 1), 1, nt - 1);
        BAR; WAIT_L(0); MMA(0, 0, At, B0); BAR;
        LDB(B1, 0, 1); BAR; WAIT_L(0); MMA(0, 1, At, B1); BAR;
        LDA(At, 0, 1); WAIT_V(4); BAR; WAIT_L(0); MMA(1, 0, At, B0); MMA(1, 1, At, B1); BAR; }
      { LDB(B0, 1, 0); LDA(At, 1, 0); WAIT_V(2); BAR; WAIT_L(0); MMA(0, 0, At, B0); BAR;
        LDB(B1, 1, 1); WAIT_V(0); BAR; WAIT_L(0); MMA(0, 1, At, B1); BAR;
        LDA(At, 1, 1); BAR; WAIT_L(0); MMA(1, 0, At, B0); MMA(1, 1, At, B1); BAR; }
      if (wr == 0) BAR;
      if (br < 2) {
        cA = (const char*)(Y + (br + 1) * 1024) + (size_t)pm * 256 * lda * 2;
        cB = (const char*)(W + (size_t)(br + 1) * (SZ_WBR1 / 2)) + (size_t)pn * 256 * ldb * 2;
        ISSUE_PROLOGUE();
      } else {
        ++rnd; have = tile_order(rnd * gridDim.x + blockIdx.x, 64, 8, pm2, pn2);
        if (have) { cA = (const char*)Y + (size_t)pm2 * 256 * lda * 2; cB = (const char*)W + (size_t)pn2 * 256 * ldb * 2; ISSUE_PROLOGUE(); }
      }
      int lane2 = __builtin_amdgcn_mbcnt_hi(~0u, __builtin_amdgcn_mbcnt_lo(~0u, 0u)); asm volatile("" : "+v"(lane2));
      const int cl = wc * 32 + 8 * (lane2 >> 4), fr_e = lane2 & 15;
      const bf16_t* gcur = (const bf16_t*)(ws + OFF_GATES) + br * DM + ocol;
      const bf16_t* gnxt = gcur + DM;
      bf16_t* mbase = (bf16_t*)(ws + OFF_PROJ) + ocol;
#pragma unroll
      for (int ai = 0; ai < 2; ++ai)
#pragma unroll
        for (int mh = 0; mh < 2; ++mh) {
          u32x4 gg[2][2], gn[2][2];
#pragma unroll
          for (int m2 = 0; m2 < 2; ++m2) {
            const int rl = ai * HALF + wr * 64 + (mh * 2 + m2) * 16 + fr_e;
            const size_t go = (size_t)(brow + rl) * GATE_LD + cl;
#pragma unroll
            for (int bj = 0; bj < 2; ++bj) {
              gg[m2][bj] = *(const u32x4*)(gcur + go + bj * HALF);
              if (br < 2) gn[m2][bj] = *(const u32x4*)(gnxt + go + bj * HALF);
            }
          }
#pragma unroll
          for (int m2 = 0; m2 < 2; ++m2) {
            const int m = mh * 2 + m2;
            const int rl = ai * HALF + wr * 64 + m * 16 + fr_e;
            bf16_t* mrow = mbase + (size_t)(brow + rl) * M_LD + cl;
#pragma unroll
            for (int bj = 0; bj < 2; ++bj) {
              const u32x4 g = gg[m2][bj];
              f32x4 v0 = acc[ai][bj][m][0], v1 = acc[ai][bj][m][1];
              if (br < 2) {
                const u32x4 d = gn[m2][bj];
                v0[0] *= bflo(g[0]) * __builtin_amdgcn_rcpf(fmaxf(bflo(d[0]), 1e-20f)); v0[1] *= bfhi(g[0]) * __builtin_amdgcn_rcpf(fmaxf(bfhi(d[0]), 1e-20f));
                v0[2] *= bflo(g[1]) * __builtin_amdgcn_rcpf(fmaxf(bflo(d[1]), 1e-20f)); v0[3] *= bfhi(g[1]) * __builtin_amdgcn_rcpf(fmaxf(bfhi(d[1]), 1e-20f));
                v1[0] *= bflo(g[2]) * __builtin_amdgcn_rcpf(fmaxf(bflo(d[2]), 1e-20f)); v1[1] *= bfhi(g[2]) * __builtin_amdgcn_rcpf(fmaxf(bfhi(d[2]), 1e-20f));
                v1[2] *= bflo(g[3]) * __builtin_amdgcn_rcpf(fmaxf(bflo(d[3]), 1e-20f)); v1[3] *= bfhi(g[3]) * __builtin_amdgcn_rcpf(fmaxf(bfhi(d[3]), 1e-20f));
                acc[ai][bj][m][0] = v0; acc[ai][bj][m][1] = v1;
              } else {
                v0[0] *= fmaxf(bflo(g[0]), 1e-20f); v0[1] *= fmaxf(bfhi(g[0]), 1e-20f); v0[2] *= fmaxf(bflo(g[1]), 1e-20f); v0[3] *= fmaxf(bfhi(g[1]), 1e-20f);
                v1[0] *= fmaxf(bflo(g[2]), 1e-20f); v1[1] *= fmaxf(bfhi(g[2]), 1e-20f); v1[2] *= fmaxf(bflo(g[3]), 1e-20f); v1[3] *= fmaxf(bfhi(g[3]), 1e-20f);
                u32x4 o; o[0] = pk_bf16(v0[0], v0[1]); o[1] = pk_bf16(v0[2], v0[3]); o[2] = pk_bf16(v1[0], v1[1]); o[3] = pk_bf16(v1[2], v1[3]);
                *(u32x4*)(mrow + bj * HALF) = o;
              }
            }
          }
        }
    }
    pm = pm2; pn = pn2;
  }
}

constexpr int KP = 272, VP = 320, KBUF = 64 * KP, VBUF = 64 * VP;
constexpr int AT_V = 3 * KBUF, AT_BT = AT_V + 3 * VBUF, AT_KB = AT_BT + 16384, AT_SM = AT_KB + 8192, AT_FL = AT_SM + 1024;

DI int rel_bucket_i(int n) {
  if (n < 16) return n;
  return 16 + (n >= 22) + (n >= 30) + (n >= 40) + (n >= 54) + (n >= 73) + (n >= 99) + (n >= 134) + (n >= 182) + (n >= 246) + (n >= 332) + (n >= 450) + (n >= 609) + (n >= 825) + (n >= 1117) + (n >= 1513);
}

template <int MODE> DI void attn_unit(KParams p, int b, int h, int qt, char* shm) {
  const int tid = opaque_tid(), lane = tid & 63, w = __builtin_amdgcn_readfirstlane(tid >> 6), r = lane & 31, hh = lane >> 5;
  const bf16_t* proj = (const bf16_t*)(p->ws + OFF_PROJ);
  const int qcol = (MODE == 0 ? 0 : 4096) + h * 128, kcol = qcol + 1024, vcol = qcol + 2048;
  const size_t tok0 = (size_t)b * SEQ;
  const int q0 = qt * 256, q0w = q0 + 32 * w, qpos = q0w + r;
  const float SC = 0.08838834764831845f * LOG2E;
  float* btab = (float*)(shm + AT_BT);
  int* flags = (int*)(shm + AT_FL);
  __syncthreads();
  bf16x8 qf[8];
  { const bf16_t* qp = proj + (tok0 + qpos) * PROJ_LD + qcol + 8 * hh;
#pragma unroll
    for (int s = 0; s < 8; ++s) qf[s] = *(const bf16x8*)(qp + 16 * s); }
  unsigned mymask = 0;
  if (MODE == 0) {
    float* kbl = (float*)(shm + AT_KB); unsigned* selm = (unsigned*)(shm + AT_SM);
    { const int kblk = tid >> 5, part = tid & 31;
      const float* kbg = (const float*)(p->ws + OFF_KBAR) + ((size_t)(b * 16 + kblk) * 2) * 1024 + h * 128 + part * 4;
      const f32x4 k0 = *(const f32x4*)kbg, k1 = *(const f32x4*)(kbg + 1024);
      *(f32x4*)(kbl + kblk * 128 + part * 4) = (k0 + k1) * (1.f / 256.f); }
#pragma unroll
    for (int i = 0; i < 8; ++i) { const int d = tid + 512 * i; btab[d] = p->rel_bias[h * 32 + rel_bucket_i(d)] * LOG2E; }
    __syncthreads();
    const int ql = tid >> 1, half = tid & 1, own = qt;
    float g[8] = {0.f, 0.f, 0.f, 0.f, 0.f, 0.f, 0.f, 0.f};
    if (own > 0) {
      const bf16_t* qp = proj + (tok0 + q0 + ql) * PROJ_LD + qcol;
#pragma unroll 2
      for (int dc = 0; dc < 16; ++dc) {
        const u32x4 qv = *(const u32x4*)(qp + dc * 8);
        float qq[8];
#pragma unroll
        for (int e = 0; e < 4; ++e) { qq[2 * e] = bflo(qv[e]); qq[2 * e + 1] = bfhi(qv[e]); }
#pragma unroll
        for (int n = 0; n < 8; ++n) {
          const float* kr = kbl + (half * 8 + n) * 128 + dc * 8;
          const f32x4 k0 = *(const f32x4*)kr, k1 = *(const f32x4*)(kr + 4);
          g[n] += qq[0] * k0[0] + qq[1] * k0[1] + qq[2] * k0[2] + qq[3] * k0[3] + qq[4] * k1[0] + qq[5] * k1[1] + qq[6] * k1[2] + qq[7] * k1[3];
        }
      }
    }
    float all[16];
#pragma unroll
    for (int n = 0; n < 8; ++n) { const float go = __shfl_xor(g[n], 1); all[n] = half ? go : g[n]; all[8 + n] = half ? g[n] : go; }
    unsigned mask = 1u << own;
    const int nsel = own < 3 ? own : 3;
#pragma unroll
    for (int t = 0; t < 3; ++t) {
      if (t < nsel) {
        float best = -3.0e38f; int bi = 0;
#pragma unroll
        for (int n = 0; n < 16; ++n) { const bool ok = (n < own) && !((mask >> n) & 1u) && (all[n] > best); best = ok ? all[n] : best; bi = ok ? n : bi; }
        mask |= 1u << bi;
      }
    }
    if (half == 0) selm[ql] = mask;
    __syncthreads();
    mymask = selm[32 * w + r];
  } else {
    if (tid < 16) flags[tid] = 0;
  }
  bf16x8 tf[2];
  if (MODE == 1) {
#pragma unroll
    for (int s = 0; s < 2; ++s)
#pragma unroll
      for (int j = 0; j < 8; ++j) { const int k = 16 * s + 8 * (j >> 2) + 4 * hh + (j & 3); tf[s][j] = (k >= r) ? (short)0x3F80 : (short)0; }
  }
  f32x16 o[4];
#pragma unroll
  for (int dt = 0; dt < 4; ++dt)
#pragma unroll
    for (int i = 0; i < 16; ++i) o[dt][i] = 0.f;
  float mrun = -1e30f, lrun = 0.f, carry = 0.f;
  const int ntiles = 4 * qt + 4;
  u32x4 kreg[2], vreg[2];
#define GLOAD(kst) do { _Pragma("unroll") for (int _i = 0; _i < 2; ++_i) { const int _c = tid + 512 * _i, _key = _c >> 4, _part = _c & 15; \
      const bf16_t* _rp = proj + (tok0 + (kst) + _key) * PROJ_LD; kreg[_i] = *(const u32x4*)(_rp + kcol + _part * 8); vreg[_i] = *(const u32x4*)(_rp + vcol + _part * 8); } } while (0)
#define LSTORE(buf) do { _Pragma("unroll") for (int _i = 0; _i < 2; ++_i) { const int _c = tid + 512 * _i, _key = _c >> 4, _part = _c & 15; \
      *(u32x4*)(shm + (buf) * KBUF + _key * KP + _part * 16) = kreg[_i]; *(u32x4*)(shm + AT_V + (buf) * VBUF + _key * VP + _part * 16) = vreg[_i]; } } while (0)
#define KST(it) (MODE == 0 ? 64 * (it) : 64 * (ntiles - 1 - (it)))
  GLOAD(KST(0)); LSTORE(0); __syncthreads();
  const int i16 = lane & 15, q4 = i16 >> 2, p4 = i16 & 3, blk16 = (lane >> 4) & 1;
  bool wdone = false;
  const bool defer = (MODE == 0) && (w >= 4);
  bf16x8 pf[4]; bool pend = false; int pendbuf = 0;
#pragma unroll
  for (int ks = 0; ks < 4; ++ks) pf[ks] = (bf16x8){0, 0, 0, 0, 0, 0, 0, 0};
#define PV_STEP(PF, B) do { const char* _vb0 = shm + AT_V + (B) * VBUF + (4 * hh + q4) * VP + 32 * blk16 + 8 * p4; \
    _Pragma("unroll") for (int dt = 0; dt < 4; ++dt) _Pragma("unroll") for (int ks = 0; ks < 4; ++ks) { \
      const char* _vb = _vb0 + (ks * 16) * VP + dt * 64; \
      const s16x4 _lo = __builtin_amdgcn_ds_read_tr16_b64_v4i16((LAS s16x4*)(_vb)); \
      const s16x4 _hi = __builtin_amdgcn_ds_read_tr16_b64_v4i16((LAS s16x4*)(_vb + 8 * VP)); \
      o[dt] = mfma32(__builtin_shufflevector(_lo, _hi, 0, 1, 2, 3, 4, 5, 6, 7), PF[ks], o[dt]); } } while (0)
  int buf = 0;
  for (int it = 0; it < ntiles; ++it) {
    const int kst = KST(it), nbuf = (buf == 2) ? 0 : buf + 1;
    if (MODE == 1 && it > 0) {
      const int* fl = flags + ((it - 1) & 1) * 8;
      const int alld = fl[0] & fl[1] & fl[2] & fl[3] & fl[4] & fl[5] & fl[6] & fl[7];
      if (alld) break;
    }
    if (it + 1 < ntiles) GLOAD(KST(it + 1));
    if (defer && pend) { PV_STEP(pf, pendbuf); pend = false; }
    bool active;
    bool sel = true;
    if (MODE == 0) {
      const int j = kst >> 8;
      if (j == qt) active = (kst - q0) <= 32 * w + 31;
      else { sel = (mymask >> j) & 1u; active = __builtin_amdgcn_ballot_w64(sel) != 0ull; }
    } else {
      active = !wdone && (kst <= q0w + 31);
    }
    if (active) {
      f32x16 st[2];
#pragma unroll
      for (int sub = 0; sub < 2; ++sub) {
        f32x16 a16;
#pragma unroll
        for (int i = 0; i < 16; ++i) a16[i] = 0.f;
        const char* kb = shm + buf * KBUF + (sub * 32 + r) * KP + hh * 16;
#pragma unroll
        for (int s = 0; s < 8; ++s) a16 = mfma32(*(const bf16x8*)(kb + s * 32), qf[s], a16);
        st[sub] = a16;
      }
      if (MODE == 0) {
        __builtin_amdgcn_s_setprio(1);
        float mx = -1e30f;
        const int dmin = q0w - (kst + 63), dmax = q0w + 31 - kst;
        const int bl = rel_bucket_i(dmin < 0 ? 0 : dmin), bh = rel_bucket_i(dmax);
        if ((kst >> 8) != qt && dmin >= 16 && bh - bl <= 1) {
          int T = 1513;
          if (dmin < 1117) T = 1117; if (dmin < 825) T = 825; if (dmin < 609) T = 609; if (dmin < 450) T = 450; if (dmin < 332) T = 332;
          if (dmin < 246) T = 246; if (dmin < 182) T = 182; if (dmin < 134) T = 134; if (dmin < 99) T = 99; if (dmin < 73) T = 73;
          if (dmin < 54) T = 54; if (dmin < 40) T = 40; if (dmin < 30) T = 30; if (dmin < 22) T = 22;
          if (bh == bl) T = -(1 << 30);
          const float bhi = btab[dmax], blo = btab[dmin];
          const float hi_l = sel ? bhi : -1e30f, lo_l = sel ? blo : -1e30f;
          const int dist0 = qpos - kst - 4 * hh;
#pragma unroll
          for (int sub = 0; sub < 2; ++sub)
#pragma unroll
            for (int i = 0; i < 16; ++i) {
              const int c = sub * 32 + (i & 3) + 8 * (i >> 2);
              const float bias = (dist0 >= T + c) ? hi_l : lo_l;
              const float v = st[sub][i] * SC + bias;
              st[sub][i] = v; mx = fmaxf(mx, v);
            }
        } else {
#pragma unroll
          for (int sub = 0; sub < 2; ++sub)
#pragma unroll
            for (int i = 0; i < 16; ++i) {
              const int key = kst + sub * 32 + (i & 3) + 8 * (i >> 2) + 4 * hh;
              const int dist = qpos - key;
              const bool valid = sel && (dist >= 0);
              const float bias = btab[dist < 0 ? 0 : dist];
              const float v = valid ? st[sub][i] * SC + bias : -1e30f;
              st[sub][i] = v; mx = fmaxf(mx, v);
            }
        }
        mx = fmaxf(mx, __shfl_xor(mx, 32));
        const float mnew = fmaxf(mrun, mx);
        float ps = 0.f;
#pragma unroll
        for (int sub = 0; sub < 2; ++sub)
#pragma unroll
          for (int i = 0; i < 16; ++i) { const float pv = fexp2(st[sub][i] - mnew); st[sub][i] = pv; ps += pv; }
        if (__builtin_amdgcn_ballot_w64(mnew > mrun) != 0ull) {
          const float alpha = fexp2(mrun - mnew);
          mrun = mnew;
          lrun *= alpha;
#pragma unroll
          for (int dt = 0; dt < 4; ++dt)
#pragma unroll
            for (int i = 0; i < 16; ++i) o[dt][i] *= alpha;
        }
        lrun += ps;
        __builtin_amdgcn_s_setprio(0);
      } else {
#pragma unroll
        for (int sub = 1; sub >= 0; --sub) {
          f32x16 sp;
#pragma unroll
          for (int i = 0; i < 16; ++i) {
            const int key = kst + sub * 32 + (i & 3) + 8 * (i >> 2) + 4 * hh;
            const bool valid = key < qpos;
            const float z = st[sub][i] * SC;
            const float s = fmaxf(z, 0.f) + flog2(1.f + fexp2(-fabsf(z)));
            sp[i] = valid ? s : 0.f; st[sub][i] = z;
          }
          f32x16 c;
#pragma unroll
          for (int i = 0; i < 16; ++i) c[i] = carry;
#pragma unroll
          for (int s2 = 0; s2 < 2; ++s2) {
            u32x4 hi, lo;
#pragma unroll
            for (int jj = 0; jj < 4; ++jj) {
              const float a0 = sp[8 * s2 + 2 * jj], a1 = sp[8 * s2 + 2 * jj + 1];
              const unsigned hv = pk_bf16(a0, a1);
              hi[jj] = hv; lo[jj] = pk_bf16(a0 - bflo(hv), a1 - bfhi(hv));
            }
            c = mfma32(tf[s2], __builtin_bit_cast(bf16x8, hi), c);
            c = mfma32(tf[s2], __builtin_bit_cast(bf16x8, lo), c);
          }
          carry = __shfl(c[0], r);
#pragma unroll
          for (int i = 0; i < 16; ++i) {
            const int key = kst + sub * 32 + (i & 3) + 8 * (i >> 2) + 4 * hh;
            const bool valid = key < qpos;
            st[sub][i] = valid ? fexp2(st[sub][i] - c[i]) : 0.f;
          }
        }
        wdone = __builtin_amdgcn_ballot_w64(carry > 152.f) == ~0ull;
      }
#pragma unroll
      for (int ks = 0; ks < 4; ++ks) {
        u32x4 t;
#pragma unroll
        for (int jj = 0; jj < 4; ++jj) t[jj] = pk_bf16(st[ks >> 1][8 * (ks & 1) + 2 * jj], st[ks >> 1][8 * (ks & 1) + 2 * jj + 1]);
        pf[ks] = __builtin_bit_cast(bf16x8, t);
      }
      if (!defer) { PV_STEP(pf, buf); }
      else { pend = true; pendbuf = buf; }
    }
    if (MODE == 1) { if (lane == 0) flags[(it & 1) * 8 + w] = (wdone || (kst == 0)) ? 1 : 0; }
    if (it + 1 < ntiles) LSTORE(nbuf);
    __syncthreads();
    buf = nbuf;
  }
  if (defer && pend) { PV_STEP(pf, pendbuf); }
#undef PV_STEP
  float inv = 1.f;
  if (MODE == 0) { const float lt = lrun + __shfl_xor(lrun, 32); inv = 1.f / lt; }
  bf16_t* yp = (bf16_t*)(p->ws + OFF_Y) + (tok0 + qpos) * Y_LD + (MODE == 0 ? 0 : 2048) + h * 128 + 4 * hh;
#pragma unroll
  for (int dt = 0; dt < 4; ++dt)
#pragma unroll
    for (int g = 0; g < 4; ++g) {
      u32x2 ov; ov[0] = pk_bf16(o[dt][4 * g] * inv, o[dt][4 * g + 1] * inv); ov[1] = pk_bf16(o[dt][4 * g + 2] * inv, o[dt][4 * g + 3] * inv);
      *(u32x2*)(yp + dt * 32 + 8 * g) = ov;
    }
#undef GLOAD
#undef LSTORE
#undef KST
}

constexpr int SBW_K = 32 * KP, SBW_V = 32 * VP, SBW_LDS = SBW_K + SBW_V;
DI void sb_unit(KParams p, int b, int h, int qt, char* shm) {
  const int tid = opaque_tid(), lane = tid & 63, w = __builtin_amdgcn_readfirstlane(tid >> 6), r = lane & 31, hh = lane >> 5;
  const bf16_t* proj = (const bf16_t*)(p->ws + OFF_PROJ);
  const int qcol = 4096 + h * 128, kcol = qcol + 1024, vcol = qcol + 2048;
  const size_t tok0 = (size_t)b * SEQ;
  const int q0w = qt * 256 + 32 * w, qpos = q0w + r;
  const float SC = 0.08838834764831845f * LOG2E;
  char* kl = shm + w * SBW_LDS; char* vl = kl + SBW_K;
  __syncthreads();
  bf16x8 qf[8];
  { const bf16_t* qp = proj + (tok0 + qpos) * PROJ_LD + qcol + 8 * hh;
#pragma unroll
    for (int s = 0; s < 8; ++s) qf[s] = *(const bf16x8*)(qp + 16 * s); }
  bf16x8 tf[2];
#pragma unroll
  for (int s = 0; s < 2; ++s)
#pragma unroll
    for (int j = 0; j < 8; ++j) { const int k = 16 * s + 8 * (j >> 2) + 4 * hh + (j & 3); tf[s][j] = (k >= r) ? (short)0x3F80 : (short)0; }
  f32x16 o[4];
#pragma unroll
  for (int dt = 0; dt < 4; ++dt)
#pragma unroll
    for (int i = 0; i < 16; ++i) o[dt][i] = 0.f;
  float carry = 0.f;
  const int i16 = lane & 15, q4 = i16 >> 2, p4 = i16 & 3, blk16 = (lane >> 4) & 1;
  u32x4 kreg[4], vreg[4];
#define SB_GLOAD(kst) do { _Pragma("unroll") for (int _i = 0; _i < 4; ++_i) { const int _c = lane + 64 * _i, _key = _c >> 3, _part = _c & 7; \
      const bf16_t* _rp = proj + (tok0 + (kst) + _key) * PROJ_LD; kreg[_i] = *(const u32x4*)(_rp + kcol + _part * 16); vreg[_i] = *(const u32x4*)(_rp + vcol + _part * 16); } } while (0)
  u32x4 kreg2[4], vreg2[4];
#define SB_GLOAD2(kst) do { _Pragma("unroll") for (int _i = 0; _i < 4; ++_i) { const int _c = lane + 64 * _i, _key = _c >> 3, _part = _c & 7; \
      const bf16_t* _rp = proj + (tok0 + (kst) + _key) * PROJ_LD; kreg2[_i] = *(const u32x4*)(_rp + kcol + _part * 16 + 8); vreg2[_i] = *(const u32x4*)(_rp + vcol + _part * 16 + 8); } } while (0)
#define SB_LSTORE() do { _Pragma("unroll") for (int _i = 0; _i < 4; ++_i) { const int _c = lane + 64 * _i, _key = _c >> 3, _part = _c & 7; \
      *(u32x4*)(kl + _key * KP + _part * 32) = kreg[_i]; *(u32x4*)(kl + _key * KP + _part * 32 + 16) = kreg2[_i]; \
      *(u32x4*)(vl + _key * VP + _part * 32) = vreg[_i]; *(u32x4*)(vl + _key * VP + _part * 32 + 16) = vreg2[_i]; } } while (0)
  int kst = q0w;
  SB_GLOAD(kst); SB_GLOAD2(kst);
  for (;;) {
    SB_LSTORE();
    const int knext = kst - 32;
    if (knext >= 0) { SB_GLOAD(knext); SB_GLOAD2(knext); }
    f32x16 st;
#pragma unroll
    for (int i = 0; i < 16; ++i) st[i] = 0.f;
    { const char* kb = kl + r * KP + hh * 16;
#pragma unroll
      for (int s = 0; s < 8; ++s) st = mfma32(*(const bf16x8*)(kb + s * 32), qf[s], st); }
    f32x16 sp;
#pragma unroll
    for (int i = 0; i < 16; ++i) {
      const int key = kst + (i & 3) + 8 * (i >> 2) + 4 * hh;
      const float z = st[i] * SC;
      const float s = fmaxf(z, 0.f) + flog2(1.f + fexp2(-fabsf(z)));
      sp[i] = (key < qpos) ? s : 0.f; st[i] = z;
    }
    f32x16 c;
#pragma unroll
    for (int i = 0; i < 16; ++i) c[i] = carry;
#pragma unroll
    for (int s2 = 0; s2 < 2; ++s2) {
      u32x4 hi, lo;
#pragma unroll
      for (int jj = 0; jj < 4; ++jj) {
        const float a0 = sp[8 * s2 + 2 * jj], a1 = sp[8 * s2 + 2 * jj + 1];
        const unsigned hv = pk_bf16(a0, a1);
        hi[jj] = hv; lo[jj] = pk_bf16(a0 - bflo(hv), a1 - bfhi(hv));
      }
      c = mfma32(tf[s2], __builtin_bit_cast(bf16x8, hi), c);
      c = mfma32(tf[s2], __builtin_bit_cast(bf16x8, lo), c);
    }
    carry = __shfl(c[0], r);
    bf16x8 pf[2];
#pragma unroll
    for (int ks = 0; ks < 2; ++ks) {
      u32x4 t;
#pragma unroll
      for (int jj = 0; jj < 4; ++jj) {
        const int i0 = 8 * ks + 2 * jj, i1 = i0 + 1;
        const int key0 = kst + (i0 & 3) + 8 * (i0 >> 2) + 4 * hh, key1 = kst + (i1 & 3) + 8 * (i1 >> 2) + 4 * hh;
        const float a0 = (key0 < qpos) ? fexp2(st[i0] - c[i0]) : 0.f, a1 = (key1 < qpos) ? fexp2(st[i1] - c[i1]) : 0.f;
        t[jj] = pk_bf16(a0, a1);
      }
      pf[ks] = __builtin_bit_cast(bf16x8, t);
    }
    const char* vb0 = vl + (4 * hh + q4) * VP + 32 * blk16 + 8 * p4;
#pragma unroll
    for (int dt = 0; dt < 4; ++dt)
#pragma unroll
      for (int ks = 0; ks < 2; ++ks) {
        const char* vb = vb0 + (ks * 16) * VP + dt * 64;
        const s16x4 lo = __builtin_amdgcn_ds_read_tr16_b64_v4i16((LAS s16x4*)(vb));
        const s16x4 hi = __builtin_amdgcn_ds_read_tr16_b64_v4i16((LAS s16x4*)(vb + 8 * VP));
        o[dt] = mfma32(__builtin_shufflevector(lo, hi, 0, 1, 2, 3, 4, 5, 6, 7), pf[ks], o[dt]);
      }
    if (knext < 0 || __builtin_amdgcn_ballot_w64(carry > 152.f) == ~0ull) break;
    kst = knext;
  }
#undef SB_GLOAD
#undef SB_GLOAD2
#undef SB_LSTORE
  bf16_t* yp = (bf16_t*)(p->ws + OFF_Y) + (tok0 + qpos) * Y_LD + 2048 + h * 128 + 4 * hh;
#pragma unroll
  for (int dt = 0; dt < 4; ++dt)
#pragma unroll
    for (int g = 0; g < 4; ++g) {
      u32x2 ov; ov[0] = pk_bf16(o[dt][4 * g], o[dt][4 * g + 1]); ov[1] = pk_bf16(o[dt][4 * g + 2], o[dt][4 * g + 3]);
      *(u32x2*)(yp + dt * 32 + 8 * g) = ov;
    }
}

DI void attention_phase(KParams p, char* shm) {
  for (int k = blockIdx.x; k < 256; k += gridDim.x)
    for (int s = 0; s < 2; ++s) { const int u = s ? 511 - k : k; attn_unit<0>(p, (u & 31) >> 3, u & 7, 15 - (u >> 5), shm); }
  for (int k = blockIdx.x; k < 256; k += gridDim.x)
    for (int s = 0; s < 2; ++s) { const int u = s ? 511 - k : k; sb_unit(p, (u & 31) >> 3, u & 7, 15 - (u >> 5), shm); }
}

constexpr int NPHASE = 15;
DI void run_phase(KParams p, int ph, char* shm) {
  asm volatile("" : "+s"(p));
  char* ws = p->ws;
  const int l = ph == 0 ? 0 : (ph - 1) / 7, sp0 = ph == 0 ? -1 : (ph - 1) % 7, sp = sp0 >= 1 ? sp0 + 1 : sp0;
  if (ph == 0 || (sp == 7 && l == 0)) { convert_layer(p, ph == 0 ? 0 : 1, shm); if (ph == 0) x_prep(p); return; }
  if (sp == 7) { final_norm(p); return; }
  if (sp == 2) attention_phase(p, shm);
  if (sp == 3) { branch_phase(p, shm); return; }
  const bf16_t* A; const bf16_t* Bt; int lda, ldb, K, nN, kind, nsub = 1, acs = 0, oc0 = 0, ocs = 256; const float* hin = nullptr;
  size_t asub = 0, bsub = 0;
  if (sp == 0) { A = (const bf16_t*)(ws + OFF_XB); lda = XB_LD; Bt = (const bf16_t*)(ws + OFF_WIN); ldb = DM; K = DM; nN = 52; kind = EPI_IN; }
  else if (sp == 2) { A = (const bf16_t*)(ws + OFF_P); lda = P_LD; Bt = (const bf16_t*)(ws + OFF_WPOOL); ldb = 256; K = 256; nN = 4; kind = EPI_POOL; acs = 256; oc0 = 1024; }
  else if (sp == 3) { A = (const bf16_t*)(ws + OFF_Y); lda = Y_LD; Bt = (const bf16_t*)(ws + OFF_WBR); ldb = 1024; K = 1024; nN = 8; kind = EPI_BR; nsub = 3; asub = 1024; bsub = SZ_WBR1 / 2; }
  else if (sp == 4) { A = (const bf16_t*)(ws + OFF_PROJ); lda = M_LD; Bt = (const bf16_t*)(ws + OFF_WOUT); ldb = DM; K = DM; nN = 8; kind = EPI_RES; }
  else if (sp == 5) { A = (const bf16_t*)(ws + OFF_XB); lda = XB_LD; Bt = (const bf16_t*)(ws + OFF_WGU); ldb = DM; K = DM; nN = 44; kind = EPI_FFN1; ocs = 128; }
  else { A = (const bf16_t*)(ws + OFF_PROJ); lda = ACT_LD; Bt = (const bf16_t*)(ws + OFF_WDOWN); ldb = DFF; K = DFF; nN = 8; kind = EPI_RES; }
  gemm_phase(p, A, lda, Bt, ldb, K, nN, kind, nsub, asub, bsub, acs, oc0, ocs, hin, shm);
}

constexpr int LDS_BYTES = 8 * SBW_LDS + 16 > GEMM_LDS + 2048 + 16 ? 8 * SBW_LDS + 16 : GEMM_LDS + 2048 + 16;

__global__ void __launch_bounds__(512, 2) hybrid_megakernel(Params p_arg) {
  extern __shared__ __attribute__((aligned(16))) char shm[];
  KParams kp = (KParams)__builtin_amdgcn_kernarg_segment_ptr();
  const int phase_lo = kp->phase_lo, phase_hi = kp->phase_hi;
  volatile LAS unsigned* xst = (volatile LAS unsigned*)(LAS char*)(shm + LDS_BYTES - 16);
  const bool multi = phase_hi - phase_lo > 1;
  XcdBarrier xb{};
  if (multi) {
    if (threadIdx.x == 0) { xst[0] = 0u; xst[1] = 0u; }
    __syncthreads();
    xb = xcd_barrier_post((unsigned*)(kp->ws + OFF_BAR), xst);
  }
  for (int ph = phase_lo; ph < phase_hi; ++ph) {
    if (ph > phase_lo) { if (ph == 1) cg::this_grid().sync(); else xcd_barrier(xb, (unsigned*)(kp->ws + OFF_BAR)); }
    run_phase(kp, ph, shm);
  }
}

#ifndef SINGLE_LAUNCH
#define SINGLE_LAUNCH 1
#endif

extern "C" void kernel_launch(void* const* d_in, const int* in_sizes, int n_in, void* d_out, int out_size, void* d_ws, size_t ws_size, hipStream_t stream) {
  static int grid_blocks = 0;
  if (!grid_blocks) {
    hipFuncSetAttribute((const void*)hybrid_megakernel, hipFuncAttributeMaxDynamicSharedMemorySize, LDS_BYTES);
    int dev = 0, cus = 0, per_cu = 0;
    hipGetDevice(&dev);
    hipDeviceGetAttribute(&cus, hipDeviceAttributeMultiprocessorCount, dev);
    hipOccupancyMaxActiveBlocksPerMultiprocessor(&per_cu, hybrid_megakernel, 512, LDS_BYTES);
    if (per_cu < 1) per_cu = 1;
    grid_blocks = cus * per_cu;
    if (ws_size < WS_NEED) fprintf(stderr, "workspace too small: %zu < %zu\n", ws_size, (size_t)WS_NEED);
  }
  Params p{};
  p.x = (const float*)d_in[0]; p.norm_mix = (const float*)d_in[1]; p.norm_ffn = (const float*)d_in[2]; p.w_in = (const float*)d_in[3];
  p.w_pool = (const float*)d_in[4]; p.pool_scale = (const float*)d_in[5]; p.w_br_a = (const float*)d_in[6]; p.w_br_b = (const float*)d_in[7];
  p.w_br_c = (const float*)d_in[8]; p.w_out = (const float*)d_in[9]; p.w_gate = (const float*)d_in[10]; p.w_up = (const float*)d_in[11];
  p.w_down = (const float*)d_in[12]; p.rel_bias = (const float*)d_in[13]; p.norm_final = (const float*)d_in[14];
  p.out = (float*)d_out; p.ws = (char*)d_ws;
#if SINGLE_LAUNCH
  hipMemsetAsync((char*)d_ws + OFF_BAR, 0, 16384, stream);
  p.phase_lo = 0; p.phase_hi = NPHASE;
  void* args[] = {&p};
  hipError_t e = hipLaunchCooperativeKernel((const void*)hybrid_megakernel, dim3(grid_blocks), dim3(512), args, LDS_BYTES, stream);
  if (e != hipSuccess) fprintf(stderr, "cooperative launch failed: %s (grid %d)\n", hipGetErrorString(e), grid_blocks);
#else
  for (int ph = 0; ph < NPHASE; ++ph) {
    p.phase_lo = ph; p.phase_hi = ph + 1;
    hipLaunchKernelGGL(hybrid_megakernel, dim3(grid_blocks), dim3(512), LDS_BYTES, stream, p);
  }
#endif
}
```
